# Optimizing an MI355X kernel written in HIP

```python
import math
import jax, jax.numpy as jnp
from jax import lax
import numpy as np

D_MODEL = 1024
BATCH = 4
SEQ = 8192
DEPTH = 1

CHUNK = 64

D_MIX = D_MODEL
D_POOL = D_MIX // 2
D_SSM = D_MIX - D_POOL
POOL_WINDOWS = (2, 4, 8, 16)
N_POOL_GROUPS = len(POOL_WINDOWS)
POOL_GROUP = D_POOL // N_POOL_GROUPS
SSM_GROUP = 16
N_SSM_GROUPS = D_SSM // SSM_GROUP
SSM_STATE = 64
DT_MIN = 1e-3
DT_MAX = 1e-1

N_EXPERT_GROUPS = 4
EXPERTS_PER_GROUP = 4
N_EXPERTS = N_EXPERT_GROUPS * EXPERTS_PER_GROUP
TOP_K_INNER = 2
D_EXPERT = D_MODEL // 4

EPS = 1e-6

kernel_name = "hymba_pool_s5_hier_moe_block"


def rms_norm(x, g):
    xf = x.astype(jnp.float32)
    y = xf * lax.rsqrt(jnp.mean(xf * xf, axis=-1, keepdims=True) + EPS)
    return (y * g.astype(jnp.float32)).astype(x.dtype)


def pool_mixer(u, pool_w, pool_scale):
    bsz, l, _ = u.shape
    uf = u.astype(jnp.float32)
    cs = jnp.pad(jnp.cumsum(uf, axis=1), ((0, 0), (1, 0), (0, 0)))
    pos = jnp.arange(l)
    outs = []
    for gi, w in enumerate(POOL_WINDOWS):
        c = cs[:, :, gi * POOL_GROUP:(gi + 1) * POOL_GROUP]
        start = jnp.maximum(pos + 1 - w, 0)
        win_sum = c[:, 1:] - c[:, start]
        count = jnp.minimum(pos + 1, w).astype(jnp.float32)
        outs.append(win_sum / count[None, :, None] - uf[:, :, gi * POOL_GROUP:(gi + 1) * POOL_GROUP])
    p = jnp.stack(outs, axis=2)
    p = jnp.einsum('blgc,gcd->blgd', p, pool_w.astype(jnp.float32))
    return (p.reshape(bsz, l, D_POOL) * pool_scale.astype(jnp.float32)).astype(u.dtype)


def _complex_scan_combine(e1, e2):
    a1r, a1i, b1r, b1i = e1
    a2r, a2i, b2r, b2i = e2
    ar = a2r * a1r - a2i * a1i
    ai = a2r * a1i + a2i * a1r
    br = a2r * b1r - a2i * b1i + b2r
    bi = a2r * b1i + a2i * b1r + b2i
    return ar, ai, br, bi


def s5_mixer(u, a_re, a_im, log_step, b_re, b_im, c_re, c_im, d_skip, glu_w, glu_b):
    f32 = jnp.float32
    bsz, l, _ = u.shape
    uf = u.astype(f32).reshape(bsz, l, N_SSM_GROUPS, SSM_GROUP)
    lr = a_re.astype(f32)
    li = a_im.astype(f32)
    step = jnp.exp(log_step.astype(f32))[:, None]
    mag = jnp.exp(lr * step)
    ab_re = mag * jnp.cos(li * step)
    ab_im = mag * jnp.sin(li * step)
    den = lr * lr + li * li
    nr = ab_re - 1.0
    ni = ab_im
    q_re = (nr * lr + ni * li) / den
    q_im = (ni * lr - nr * li) / den
    br = b_re.astype(f32)
    bi = b_im.astype(f32)
    bb_re = q_re[..., None] * br - q_im[..., None] * bi
    bb_im = q_re[..., None] * bi + q_im[..., None] * br
    bu_re = jnp.einsum('blgh,gph->blgp', uf, bb_re)
    bu_im = jnp.einsum('blgh,gph->blgp', uf, bb_im)
    a_seq_re = jnp.broadcast_to(ab_re, (1, l) + ab_re.shape)
    a_seq_im = jnp.broadcast_to(ab_im, (1, l) + ab_im.shape)
    _, _, x_re, x_im = lax.associative_scan(
        _complex_scan_combine, (a_seq_re, a_seq_im, bu_re, bu_im), axis=1)
    y = (jnp.einsum('blgp,ghp->blgh', x_re, c_re.astype(f32))
         - jnp.einsum('blgp,ghp->blgh', x_im, c_im.astype(f32))
         + d_skip.astype(f32).reshape(N_SSM_GROUPS, SSM_GROUP) * uf)
    y = jax.nn.gelu(y.reshape(bsz, l, D_SSM))
    y = y * jax.nn.sigmoid(y @ glu_w.astype(f32) + glu_b.astype(f32))
    return y.astype(u.dtype)


def hier_moe(h, w_coarse, b_coarse, w_fine, b_fine, w_gate, w_up, w_down):
    f32 = jnp.float32
    bsz, l, d = h.shape
    t = h.reshape(-1, d)
    coarse = (t @ w_coarse).astype(f32) + b_coarse.astype(f32)
    p_coarse = jax.nn.softmax(coarse, axis=-1)
    g_idx = jnp.argmax(coarse, axis=-1)
    p_g = jnp.take_along_axis(p_coarse, g_idx[:, None], axis=-1)
    fine = ((t @ w_fine).astype(f32) + b_fine.astype(f32)).reshape(-1, N_EXPERT_GROUPS, EXPERTS_PER_GROUP)
    fine_sel = jnp.take_along_axis(fine, g_idx[:, None, None], axis=1)[:, 0]
    top_v, top_i = lax.top_k(fine_sel, TOP_K_INNER)
    w_sel = jax.nn.softmax(top_v, axis=-1) * p_g
    e_idx = g_idx[:, None] * EXPERTS_PER_GROUP + top_i
    gates = jnp.sum(jax.nn.one_hot(e_idx, N_EXPERTS, dtype=f32) * w_sel[..., None], axis=1)
    out = jnp.zeros(t.shape, f32)
    for e in range(N_EXPERTS):
        a = jax.nn.silu(t @ w_gate[e]) * (t @ w_up[e])
        out = out + gates[:, e:e + 1] * (a @ w_down[e]).astype(f32)
    return out.reshape(bsz, l, d).astype(h.dtype)


def setup_inputs(seed: int = 0) -> dict:
    key = jax.random.key(seed)
    ks = jax.random.split(key, 26)
    f32 = jnp.float32
    nrm = lambda k, shape, s: (jax.random.normal(k, shape, f32) * s).astype(f32)
    x = jax.random.normal(ks[0], (BATCH, SEQ, D_MODEL), f32)
    norm_mix = 1.0 + nrm(ks[1], (DEPTH, D_MODEL), 0.02)
    w_in = nrm(ks[2], (DEPTH, D_MODEL, D_MIX), D_MODEL ** -0.5)
    pool_w = nrm(ks[3], (DEPTH, N_POOL_GROUPS, POOL_GROUP, POOL_GROUP), POOL_GROUP ** -0.5)
    pool_scale = 1.0 + nrm(ks[4], (DEPTH, D_POOL), 0.02)
    n = jnp.arange(SSM_STATE, dtype=f32)
    ssm_a_re = -0.5 + nrm(ks[5], (DEPTH, N_SSM_GROUPS, SSM_STATE), 0.01)
    ssm_a_im = math.pi * n[None, None, :] + nrm(ks[6], (DEPTH, N_SSM_GROUPS, SSM_STATE), 0.01)
    ssm_log_step = jax.random.uniform(ks[7], (DEPTH, N_SSM_GROUPS), f32,
                                      math.log(DT_MIN), math.log(DT_MAX))
    ssm_b_re = nrm(ks[8], (DEPTH, N_SSM_GROUPS, SSM_STATE, SSM_GROUP), (2 * SSM_GROUP) ** -0.5)
    ssm_b_im = nrm(ks[9], (DEPTH, N_SSM_GROUPS, SSM_STATE, SSM_GROUP), (2 * SSM_GROUP) ** -0.5)
    ssm_c_re = nrm(ks[10], (DEPTH, N_SSM_GROUPS, SSM_GROUP, SSM_STATE), (2 * SSM_STATE) ** -0.5)
    ssm_c_im = nrm(ks[11], (DEPTH, N_SSM_GROUPS, SSM_GROUP, SSM_STATE), (2 * SSM_STATE) ** -0.5)
    ssm_d = 1.0 + nrm(ks[12], (DEPTH, D_SSM), 0.1)
    glu_w = nrm(ks[13], (DEPTH, D_SSM, D_SSM), D_SSM ** -0.5)
    glu_b = nrm(ks[14], (DEPTH, D_SSM), 0.02)
    w_out = nrm(ks[15], (DEPTH, D_MIX, D_MODEL), D_MIX ** -0.5)
    norm_ffn = 1.0 + nrm(ks[16], (DEPTH, D_MODEL), 0.02)
    router_coarse_w = nrm(ks[17], (DEPTH, D_MODEL, N_EXPERT_GROUPS), D_MODEL ** -0.5)
    router_coarse_b = nrm(ks[18], (DEPTH, N_EXPERT_GROUPS), 0.01)
    router_fine_w = nrm(ks[19], (DEPTH, D_MODEL, N_EXPERTS), D_MODEL ** -0.5)
    router_fine_b = nrm(ks[20], (DEPTH, N_EXPERTS), 0.01)
    exp_w_gate = nrm(ks[21], (DEPTH, N_EXPERTS, D_MODEL, D_EXPERT), D_MODEL ** -0.5)
    exp_w_up = nrm(ks[22], (DEPTH, N_EXPERTS, D_MODEL, D_EXPERT), D_MODEL ** -0.5)
    exp_w_down = nrm(ks[23], (DEPTH, N_EXPERTS, D_EXPERT, D_MODEL), D_EXPERT ** -0.5)
    norm_final = 1.0 + nrm(ks[24], (D_MODEL,), 0.02)
    return {"x": x, "norm_mix": norm_mix, "w_in": w_in, "pool_w": pool_w, "pool_scale": pool_scale,
            "ssm_a_re": ssm_a_re, "ssm_a_im": ssm_a_im, "ssm_log_step": ssm_log_step,
            "ssm_b_re": ssm_b_re, "ssm_b_im": ssm_b_im, "ssm_c_re": ssm_c_re, "ssm_c_im": ssm_c_im,
            "ssm_d": ssm_d, "glu_w": glu_w, "glu_b": glu_b, "w_out": w_out, "norm_ffn": norm_ffn,
            "router_coarse_w": router_coarse_w, "router_coarse_b": router_coarse_b,
            "router_fine_w": router_fine_w, "router_fine_b": router_fine_b,
            "exp_w_gate": exp_w_gate, "exp_w_up": exp_w_up, "exp_w_down": exp_w_down,
            "norm_final": norm_final}


def reference(x, norm_mix, w_in, pool_w, pool_scale, ssm_a_re, ssm_a_im, ssm_log_step,
              ssm_b_re, ssm_b_im, ssm_c_re, ssm_c_im, ssm_d, glu_w, glu_b, w_out, norm_ffn,
              router_coarse_w, router_coarse_b, router_fine_w, router_fine_b,
              exp_w_gate, exp_w_up, exp_w_down, norm_final):
    for i in range(DEPTH):
        hn = rms_norm(x, norm_mix[i])
        z = hn @ w_in[i]
        y_pool = pool_mixer(z[..., :D_POOL], pool_w[i], pool_scale[i])
        y_ssm = s5_mixer(z[..., D_POOL:], ssm_a_re[i], ssm_a_im[i], ssm_log_step[i],
                         ssm_b_re[i], ssm_b_im[i], ssm_c_re[i], ssm_c_im[i], ssm_d[i],
                         glu_w[i], glu_b[i])
        x = x + jnp.concatenate([y_pool, y_ssm], axis=-1) @ w_out[i]
        x = x + hier_moe(rms_norm(x, norm_ffn[i]), router_coarse_w[i], router_coarse_b[i],
                         router_fine_w[i], router_fine_b[i],
                         exp_w_gate[i], exp_w_up[i], exp_w_down[i])
    return rms_norm(x, norm_final)
```

```cpp
#include <hip/hip_runtime.h>
#include <stdint.h>

#define T_TOK 32768
#define SEQ 8192
#define DM 1024
#define EPSV 1e-6f

__global__ void __launch_bounds__(256) k_rmsnorm(const float* __restrict__ in, const float* __restrict__ g, float* __restrict__ out) {
    __shared__ float red[4];
    const int row = blockIdx.x, tid = threadIdx.x;
    const float4 v = *(const float4*)(in + (size_t)row * DM + tid * 4);
    float s = v.x * v.x + v.y * v.y + v.z * v.z + v.w * v.w;
    for (int o = 32; o > 0; o >>= 1) s += __shfl_xor(s, o);
    if ((tid & 63) == 0) red[tid >> 6] = s;
    __syncthreads();
    const float tot = red[0] + red[1] + red[2] + red[3];
    const float r = rsqrtf(tot * (1.0f / DM) + EPSV);
    const float4 gg = *(const float4*)(g + tid * 4);
    float4 o4; o4.x = v.x * r * gg.x; o4.y = v.y * r * gg.y; o4.z = v.z * r * gg.z; o4.w = v.w * r * gg.w;
    *(float4*)(out + (size_t)row * DM + tid * 4) = o4;
}

struct EpiStore { float* C; int ldc; int pad; __device__ void operator()(int r, int c, float v) const { C[(size_t)r * ldc + c] = v; } };
struct EpiScaleCol { float* C; const float* sc; int ldc; int pad; __device__ void operator()(int r, int c, float v) const { C[(size_t)r * ldc + c] = v * sc[c]; } };
struct EpiGlu { float* C; const float* Y; const float* b; int ldc; int ldy; __device__ void operator()(int r, int c, float v) const {
    const float gate = v + b[c]; const float y = Y[(size_t)r * ldy + c]; C[(size_t)r * ldc + c] = y / (1.0f + expf(-gate)); } };
struct EpiResid { float* C; const float* X; int ldc; int pad; __device__ void operator()(int r, int c, float v) const { C[(size_t)r * ldc + c] = X[(size_t)r * ldc + c] + v; } };

template <class Epi>
__global__ void __launch_bounds__(256) k_sgemm(const float* __restrict__ A, const float* __restrict__ B, int lda, int ldb, int K, int pad_, Epi epi) {
    __shared__ float As[16][65];
    __shared__ float Bs[16][65];
    const int tx = threadIdx.x & 15, ty = threadIdx.x >> 4;
    const int row0 = blockIdx.y * 64, col0 = blockIdx.x * 64;
    float acc[4][4] = {};
    for (int k0 = 0; k0 < K; k0 += 16) {
        for (int e = threadIdx.x; e < 64 * 16; e += 256) { const int r = e >> 4, c = e & 15; As[c][r] = A[(size_t)(row0 + r) * lda + k0 + c]; }
        for (int e = threadIdx.x; e < 16 * 64; e += 256) { const int r = e >> 6, c = e & 63; Bs[r][c] = B[(size_t)(k0 + r) * ldb + col0 + c]; }
        __syncthreads();
#pragma unroll
        for (int k = 0; k < 16; ++k) {
            float a[4], b[4];
#pragma unroll
            for (int i = 0; i < 4; ++i) { a[i] = As[k][ty * 4 + i]; b[i] = Bs[k][tx * 4 + i]; }
#pragma unroll
            for (int i = 0; i < 4; ++i)
#pragma unroll
                for (int j = 0; j < 4; ++j) acc[i][j] += a[i] * b[j];
        }
        __syncthreads();
    }
#pragma unroll
    for (int i = 0; i < 4; ++i)
#pragma unroll
        for (int j = 0; j < 4; ++j) epi(row0 + ty * 4 + i, col0 + tx * 4 + j, acc[i][j]);
}

__global__ void __launch_bounds__(256) k_pool(const float* __restrict__ Z, float* __restrict__ P) {
    const size_t idx = (size_t)blockIdx.x * 256 + threadIdx.x;
    const int t = (int)(idx >> 9), c = (int)(idx & 511);
    const int gi = c >> 7; const int w = 2 << gi;
    const int pos = t & (SEQ - 1);
    const int cnt = (pos + 1 < w) ? (pos + 1) : w;
    float s = 0.f;
    for (int j = 0; j < cnt; ++j) s += Z[(size_t)(t - j) * DM + c];
    P[(size_t)t * 512 + c] = s / (float)cnt - Z[(size_t)t * DM + c];
}

__global__ void __launch_bounds__(64) k_ssm(const float* __restrict__ Z, const float* __restrict__ a_re, const float* __restrict__ a_im, const float* __restrict__ log_step,
                                            const float* __restrict__ b_re, const float* __restrict__ b_im, const float* __restrict__ c_re, const float* __restrict__ c_im,
                                            const float* __restrict__ dsk, float* __restrict__ Y) {
    __shared__ float xs[2][64];
    __shared__ float us[16];
    const int b = blockIdx.x >> 5, g = blockIdx.x & 31, p = threadIdx.x;
    const float lr = a_re[g * 64 + p], li = a_im[g * 64 + p];
    const float step = expf(log_step[g]);
    const float mag = expf(lr * step);
    const float abr = mag * cosf(li * step), abi = mag * sinf(li * step);
    const float den = lr * lr + li * li;
    const float nr = abr - 1.0f, ni = abi;
    const float qr = (nr * lr + ni * li) / den, qi = (ni * lr - nr * li) / den;
    float bbr[16], bbi[16];
#pragma unroll
    for (int h = 0; h < 16; ++h) { const float br = b_re[(g * 64 + p) * 16 + h], bi = b_im[(g * 64 + p) * 16 + h]; bbr[h] = qr * br - qi * bi; bbi[h] = qr * bi + qi * br; }
    float xr = 0.f, xi = 0.f;
    const int h = p & 15;
    const float dh = dsk[g * 16 + h];
    for (int t = 0; t < SEQ; ++t) {
        const size_t row = (size_t)b * SEQ + t;
        if (p < 16) us[p] = Z[row * DM + 512 + g * 16 + p];
        __syncthreads();
        float bur = 0.f, bui = 0.f;
#pragma unroll
        for (int hh = 0; hh < 16; ++hh) { const float u = us[hh]; bur += u * bbr[hh]; bui += u * bbi[hh]; }
        const float nxr = abr * xr - abi * xi + bur;
        const float nxi = abr * xi + abi * xr + bui;
        xr = nxr; xi = nxi;
        xs[0][p] = xr; xs[1][p] = xi;
        __syncthreads();
        if (p < 16) {
            float y = 0.f;
            for (int q = 0; q < 64; ++q) y += xs[0][q] * c_re[(g * 16 + h) * 64 + q] - xs[1][q] * c_im[(g * 16 + h) * 64 + q];
            y += dh * us[h];
            const float gl = 0.5f * y * (1.0f + tanhf(0.7978845608028654f * (y + 0.044715f * y * y * y)));
            Y[row * 512 + g * 16 + h] = gl;
        }
        __syncthreads();
    }
}

struct Route { int e0, e1; float w0, w1; };
__global__ void __launch_bounds__(256) k_router(const float* __restrict__ HN, const float* __restrict__ wc, const float* __restrict__ bc, const float* __restrict__ wf, const float* __restrict__ bf,
                                                Route* __restrict__ R) {
    const int tok = blockIdx.x * 4 + (threadIdx.x >> 6), lane = threadIdx.x & 63;
    float lg[20];
#pragma unroll
    for (int j = 0; j < 20; ++j) lg[j] = 0.f;
    for (int k = lane; k < DM; k += 64) {
        const float v = HN[(size_t)tok * DM + k];
#pragma unroll
        for (int j = 0; j < 4; ++j) lg[j] += v * wc[k * 4 + j];
#pragma unroll
        for (int j = 0; j < 16; ++j) lg[4 + j] += v * wf[k * 16 + j];
    }
#pragma unroll
    for (int j = 0; j < 20; ++j) for (int o = 32; o > 0; o >>= 1) lg[j] += __shfl_xor(lg[j], o);
    if (lane == 0) {
        float c[4]; int gi = 0; float mx;
        for (int j = 0; j < 4; ++j) c[j] = lg[j] + bc[j];
        mx = c[0]; for (int j = 1; j < 4; ++j) if (c[j] > mx) { mx = c[j]; gi = j; }
        float se = 0.f; for (int j = 0; j < 4; ++j) se += expf(c[j] - mx);
        const float pg = 1.0f / se;
        float f[4]; for (int j = 0; j < 4; ++j) f[j] = lg[4 + gi * 4 + j] + bf[gi * 4 + j];
        int i0 = 0; for (int j = 1; j < 4; ++j) if (f[j] > f[i0]) i0 = j;
        int i1 = -1; for (int j = 0; j < 4; ++j) if (j != i0 && (i1 < 0 || f[j] > f[i1])) i1 = j;
        const float e1 = expf(f[i1] - f[i0]);
        Route r; r.e0 = gi * 4 + i0; r.e1 = gi * 4 + i1; r.w0 = pg / (1.0f + e1); r.w1 = pg * e1 / (1.0f + e1);
        R[tok] = r;
    }
}

__global__ void __launch_bounds__(256) k_moe_final(const float* __restrict__ HN, const float* __restrict__ X1, const Route* __restrict__ R,
                                                   const float* __restrict__ wg, const float* __restrict__ wu, const float* __restrict__ wd,
                                                   const float* __restrict__ g3, float* __restrict__ out) {
    __shared__ float hs[DM];
    __shared__ float as[256];
    __shared__ float red[4];
    const int tok = blockIdx.x, tid = threadIdx.x;
    for (int k = tid; k < DM; k += 256) hs[k] = HN[(size_t)tok * DM + k];
    __syncthreads();
    const Route r = R[tok];
    float o[4] = {0.f, 0.f, 0.f, 0.f};
    for (int s = 0; s < 2; ++s) {
        const int e = s ? r.e1 : r.e0; const float w = s ? r.w1 : r.w0;
        const float* G = wg + (size_t)e * DM * 256; const float* U = wu + (size_t)e * DM * 256; const float* Dn = wd + (size_t)e * 256 * DM;
        float ga = 0.f, ua = 0.f;
        for (int k = 0; k < DM; ++k) { const float hv = hs[k]; ga += hv * G[(size_t)k * 256 + tid]; ua += hv * U[(size_t)k * 256 + tid]; }
        const float a = (ga / (1.0f + expf(-ga))) * ua;
        __syncthreads();
        as[tid] = a * w;
        __syncthreads();
        for (int f = 0; f < 256; ++f) { const float av = as[f];
#pragma unroll
            for (int j = 0; j < 4; ++j) o[j] += av * Dn[(size_t)f * DM + tid + 256 * j]; }
    }
    float x2[4]; float ss = 0.f;
#pragma unroll
    for (int j = 0; j < 4; ++j) { x2[j] = X1[(size_t)tok * DM + tid + 256 * j] + o[j]; ss += x2[j] * x2[j]; }
    for (int of = 32; of > 0; of >>= 1) ss += __shfl_xor(ss, of);
    if ((tid & 63) == 0) red[tid >> 6] = ss;
    __syncthreads();
    const float tot = red[0] + red[1] + red[2] + red[3];
    const float rs = rsqrtf(tot * (1.0f / DM) + EPSV);
#pragma unroll
    for (int j = 0; j < 4; ++j) out[(size_t)tok * DM + tid + 256 * j] = x2[j] * rs * g3[tid + 256 * j];
}

extern "C" void kernel_launch(void* const* d_in, const int* in_sizes, int n_in, void* d_out, int out_size, void* d_ws, size_t ws_size, hipStream_t stream) {
    const float* x = (const float*)d_in[0];
    const float* norm_mix = (const float*)d_in[1];
    const float* w_in = (const float*)d_in[2];
    const float* pool_w = (const float*)d_in[3];
    const float* pool_scale = (const float*)d_in[4];
    const float* a_re = (const float*)d_in[5];
    const float* a_im = (const float*)d_in[6];
    const float* log_step = (const float*)d_in[7];
    const float* b_re = (const float*)d_in[8];
    const float* b_im = (const float*)d_in[9];
    const float* c_re = (const float*)d_in[10];
    const float* c_im = (const float*)d_in[11];
    const float* ssm_d = (const float*)d_in[12];
    const float* glu_w = (const float*)d_in[13];
    const float* glu_b = (const float*)d_in[14];
    const float* w_out = (const float*)d_in[15];
    const float* norm_ffn = (const float*)d_in[16];
    const float* rc_w = (const float*)d_in[17];
    const float* rc_b = (const float*)d_in[18];
    const float* rf_w = (const float*)d_in[19];
    const float* rf_b = (const float*)d_in[20];
    const float* wg = (const float*)d_in[21];
    const float* wu = (const float*)d_in[22];
    const float* wd = (const float*)d_in[23];
    const float* norm_final = (const float*)d_in[24];
    float* out = (float*)d_out;

    char* ws = (char*)d_ws;
    const size_t SZ = (size_t)T_TOK * DM * 4;
    float* HN = (float*)(ws);
    float* Z = (float*)(ws + SZ);
    float* YC = (float*)(ws + 2 * SZ);
    float* P = (float*)(ws + 3 * SZ);
    float* Y = (float*)(ws + 3 * SZ + SZ / 2);
    float* X1 = out;
    Route* RR = (Route*)(ws + 3 * SZ);

    k_rmsnorm<<<T_TOK, 256, 0, stream>>>(x, norm_mix, HN);
    k_sgemm<EpiStore><<<dim3(DM / 64, T_TOK / 64), 256, 0, stream>>>(HN, w_in, DM, DM, DM, 0, EpiStore{Z, DM, 0});
    k_pool<<<T_TOK * 512 / 256, 256, 0, stream>>>(Z, P);
    for (int g = 0; g < 4; ++g)
        k_sgemm<EpiScaleCol><<<dim3(128 / 64, T_TOK / 64), 256, 0, stream>>>(P + g * 128, pool_w + (size_t)g * 128 * 128, 512, 128, 128, 0, EpiScaleCol{YC + g * 128, pool_scale + g * 128, DM, 0});
    k_ssm<<<4 * 32, 64, 0, stream>>>(Z, a_re, a_im, log_step, b_re, b_im, c_re, c_im, ssm_d, Y);
    k_sgemm<EpiGlu><<<dim3(512 / 64, T_TOK / 64), 256, 0, stream>>>(Y, glu_w, 512, 512, 512, 0, EpiGlu{YC + 512, Y, glu_b, DM, 512});
    k_sgemm<EpiResid><<<dim3(DM / 64, T_TOK / 64), 256, 0, stream>>>(YC, w_out, DM, DM, DM, 0, EpiResid{X1, x, DM, 0});
    k_rmsnorm<<<T_TOK, 256, 0, stream>>>(X1, norm_ffn, HN);
    k_router<<<T_TOK / 4, 256, 0, stream>>>(HN, rc_w, rc_b, rf_w, rf_b, RR);
    k_moe_final<<<T_TOK, 256, 0, stream>>>(HN, X1, RR, wg, wu, wd, norm_final, out);
}
```

```cpp
#include <hip/hip_runtime.h>
#include <stdint.h>
#include <string.h>
#define T_TOK 32768
#define SEQ 8192
#define DM 1024
#define EPSV 1e-6f

#define LAS __attribute__((address_space(3)))
typedef unsigned short bf16_t;
typedef short bf16x8 __attribute__((ext_vector_type(8)));
typedef float f32x4 __attribute__((ext_vector_type(4)));
typedef float f32x16 __attribute__((ext_vector_type(16)));
typedef unsigned u32x2 __attribute__((ext_vector_type(2)));
typedef unsigned u32x4 __attribute__((ext_vector_type(4)));

#define NTHR 512
#define LDS_BYTES 163840
#define STAGE_B 49152
#define MISC_OFF (3 * STAGE_B)

__device__ __forceinline__ unsigned cvt_pk_bf16(float lo, float hi) { unsigned r; asm("v_cvt_pk_bf16_f32 %0, %1, %2" : "=v"(r) : "v"(lo), "v"(hi)); return r; }
__device__ __forceinline__ bf16_t f2bf(float f) { return (bf16_t)(cvt_pk_bf16(f, 0.f) & 0xffffu); }
__device__ __forceinline__ float bf2f(bf16_t h) { return __uint_as_float(((unsigned)h) << 16); }
__device__ __forceinline__ float bflo(unsigned w) { return __uint_as_float(w << 16); }
__device__ __forceinline__ float bfhi(unsigned w) { return __uint_as_float(w & 0xffff0000u); }

struct StagePtrs { const char* a[2]; const char* b[4]; long bdelta; int ksplit; };

__device__ __forceinline__ int stage_row_a(int wid, int lane, int i) { return (wid * 2 + i) * 8 + (lane >> 3); }
__device__ __forceinline__ int stage_row_b(int wid, int lane, int i) { return (wid * 4 + i) * 8 + (lane >> 3); }
__device__ __forceinline__ int stage_chunk_off(int row, int lane) { return (((lane & 7) ^ ((row >> 1) & 7)) << 4); }

__device__ __forceinline__ void stage_issue(LAS unsigned char* lds, int s, const StagePtrs& sp, int kt, int wid) {
    LAS unsigned char* base = lds + s * STAGE_B;
#pragma unroll
    for (int i = 0; i < 2; ++i) __builtin_amdgcn_global_load_lds((const unsigned*)(sp.a[i] + (size_t)kt * 128), (LAS unsigned*)(base + (wid * 2 + i) * 1024), 16, 0, 0);
    const long bofs = (kt < sp.ksplit) ? (long)kt * 128 : (long)(kt - sp.ksplit) * 128 + sp.bdelta;
#pragma unroll
    for (int i = 0; i < 4; ++i) __builtin_amdgcn_global_load_lds((const unsigned*)(sp.b[i] + bofs), (LAS unsigned*)(base + 16384 + (wid * 4 + i) * 1024), 16, 0, 0);
}

__device__ __forceinline__ void gemm_core(LAS unsigned char* lds, const StagePtrs& sp, int nkt, f32x4 (&acc)[4][4], int wid, int wr, int wc, int lane) {
    const int fr = lane & 15, fq = lane >> 4, sw = fr >> 1;
    const int offk0 = fr * 128 + ((fq ^ sw) << 4), offk1 = fr * 128 + (((4 + fq) ^ sw) << 4);
    const int aoff = wr * 8192, boff = 16384 + wc * 8192;
    asm volatile("s_waitcnt vmcnt(0) lgkmcnt(0)" ::: "memory");
    __builtin_amdgcn_s_barrier();
    asm volatile("" ::: "memory");
    stage_issue(lds, 0, sp, 0, wid);
    if (nkt > 1) stage_issue(lds, 1, sp, 1, wid);
    int s = 0;
    for (int kt = 0; kt < nkt; ++kt) {
        if (kt + 1 < nkt) asm volatile("s_waitcnt vmcnt(6) lgkmcnt(0)" ::: "memory"); else asm volatile("s_waitcnt vmcnt(0) lgkmcnt(0)" ::: "memory");
        __builtin_amdgcn_s_barrier();
        asm volatile("" ::: "memory");
        if (kt + 2 < nkt) { const int s2 = (s >= 1) ? s - 1 : 2; stage_issue(lds, s2, sp, kt + 2, wid); }
        const LAS unsigned char* st = lds + s * STAGE_B;
#pragma unroll
        for (int ks = 0; ks < 2; ++ks) {
            const int ok = ks ? offk1 : offk0;
            bf16x8 af[4], bfr[4];
#pragma unroll
            for (int m = 0; m < 4; ++m) af[m] = *(const LAS bf16x8*)(st + aoff + m * 2048 + ok);
#pragma unroll
            for (int n = 0; n < 4; ++n) bfr[n] = *(const LAS bf16x8*)(st + boff + n * 2048 + ok);
#pragma unroll
            for (int m = 0; m < 4; ++m)
#pragma unroll
                for (int n = 0; n < 4; ++n) acc[m][n] = __builtin_amdgcn_mfma_f32_16x16x32_bf16(bfr[n], af[m], acc[m][n], 0, 0, 0);
        }
        s = (s == 2) ? 0 : s + 1;
    }
}
__device__ __forceinline__ void acc_zero(f32x4 (&acc)[4][4]) {
#pragma unroll
    for (int m = 0; m < 4; ++m)
#pragma unroll
        for (int n = 0; n < 4; ++n) acc[m][n] = (f32x4){0.f, 0.f, 0.f, 0.f};
}

struct Params {
    const float* x; const float* norm_mix; const float* w_in; const float* pool_w; const float* pool_scale;
    const float* a_re; const float* a_im; const float* log_step; const float* b_re; const float* b_im; const float* c_re; const float* c_im; const float* ssm_d;
    const float* glu_w; const float* glu_b; const float* w_out; const float* norm_ffn; const float* rc_w; const float* rc_b; const float* rf_w; const float* rf_b;
    const float* wg; const float* wu; const float* wd; const float* norm_final;
    float* out;
    unsigned* ctl;
    bf16_t* xb; bf16_t* z; bf16_t* ycat; bf16_t* x1b; bf16_t* ybuf; bf16_t* hid;
    bf16_t* w_inT; bf16_t* gluT; bf16_t* w_outT; bf16_t* wguT; bf16_t* wdT; bf16_t* wrT;
    float* abar; float* a64; float* a128; bf16_t* bbT; bf16_t* cmT;
    float* send0; float* send128;
    float* rstd1; float* rstd2; float* tokw; int* perm; int* tokcls;
};

template <class F>
__device__ __forceinline__ void tr_tile(F src, bf16_t* D, size_t ldd, LAS float* tl, int tid) {
#pragma unroll
    for (int p = 0; p < 8; ++p) { const int k = p * 8 + (tid >> 6), n = tid & 63; tl[k * 65 + n] = src(k, n); }
    __syncthreads();
#pragma unroll
    for (int p = 0; p < 8; ++p) { const int n = p * 8 + (tid >> 6), k = tid & 63; D[(size_t)n * ldd + k] = f2bf(tl[k * 65 + n]); }
    __syncthreads();
}

__device__ __forceinline__ void phase0_x(const Params& P, int bid, int nblk, int tid) {
    const int wave = tid >> 6, lane = tid & 63;
    for (int row = bid * 8 + wave; row < T_TOK; row += nblk * 8) {
        const float* xr = P.x + (size_t)row * DM;
        f32x4 v[4]; float s = 0.f;
#pragma unroll
        for (int i = 0; i < 4; ++i) { v[i] = *(const f32x4*)(xr + i * 256 + lane * 4); s += v[i][0] * v[i][0] + v[i][1] * v[i][1] + v[i][2] * v[i][2] + v[i][3] * v[i][3]; }
#pragma unroll
        for (int o = 32; o > 0; o >>= 1) s += __shfl_xor(s, o);
        if (lane == 0) P.rstd1[row] = rsqrtf(s * (1.0f / DM) + EPSV);
        bf16_t* xo = P.xb + (size_t)row * DM;
#pragma unroll
        for (int i = 0; i < 4; ++i) { u32x2 w; w.x = cvt_pk_bf16(v[i][0], v[i][1]); w.y = cvt_pk_bf16(v[i][2], v[i][3]); *(u32x2*)(xo + i * 256 + lane * 4) = w; }
    }
}

__device__ __forceinline__ void phase0_w_in(const Params& P, int bid, int nblk, int tid, LAS float* tl) {
    for (int job = bid; job < 256; job += nblk) {
        const int nt = job >> 4, kt = job & 15;
        const int n0 = nt * 64, k0 = kt * 64;
        if (n0 >= 512) {
            tr_tile([&](int k, int n) { return P.norm_mix[k0 + k] * P.w_in[(size_t)(k0 + k) * DM + n0 + n]; }, P.w_inT + (size_t)n0 * DM + k0, DM, tl, tid);
        } else {
            const int g = n0 >> 7;
            const float* pw = P.pool_w + (size_t)g * 128 * 128;
            tr_tile([&](int k, int n) {
                const float* wr = P.w_in + (size_t)(k0 + k) * DM + g * 128; const int d = (n0 & 127) + n; float a = 0.f;
                for (int c = 0; c < 128; ++c) a += wr[c] * pw[c * 128 + d];
                return a * P.pool_scale[n0 + n] * P.norm_mix[k0 + k]; }, P.w_inT + (size_t)n0 * DM + k0, DM, tl, tid);
        }
    }
}

__device__ __forceinline__ void phaseA(const Params& P, LAS unsigned char* lds, int bid, int nblk, int tid) {
    const int wid = __builtin_amdgcn_readfirstlane(tid >> 6), lane = tid & 63, wr = wid >> 2, wc = wid & 3, fr = lane & 15, fq = lane >> 4;
    for (int u = bid; u < 1024; u += nblk) {
        const int i = u / nblk, b = u % nblk;
        int mt, nt;
        if (nblk == 256) { const int xcd = b & 7, idx = b >> 3; mt = (i * 8 + xcd) * 8 + (idx >> 2); nt = idx & 3; } else { mt = u >> 2; nt = u & 3; }
        StagePtrs sp; sp.ksplit = 1 << 30; sp.bdelta = 0;
#pragma unroll
        for (int j = 0; j < 2; ++j) { const int r = stage_row_a(wid, lane, j); sp.a[j] = (const char*)(P.xb + (size_t)(mt * 128 + r) * DM) + stage_chunk_off(r, lane); }
#pragma unroll
        for (int j = 0; j < 4; ++j) { const int r = stage_row_b(wid, lane, j); sp.b[j] = (const char*)(P.w_inT + (size_t)(nt * 256 + r) * DM) + stage_chunk_off(r, lane); }
        f32x4 acc[4][4]; acc_zero(acc);
        gemm_core(lds, sp, DM / 64, acc, wid, wr, wc, lane);
#pragma unroll
        for (int m = 0; m < 4; ++m) {
            const int row = mt * 128 + wr * 64 + m * 16 + fr; const float rs = P.rstd1[row];
            bf16_t* zr = P.z + (size_t)row * DM + nt * 256 + wc * 64 + 4 * fq;
#pragma unroll
            for (int n = 0; n < 4; ++n) { u32x2 w; w.x = cvt_pk_bf16(acc[m][n][0] * rs, acc[m][n][1] * rs); w.y = cvt_pk_bf16(acc[m][n][2] * rs, acc[m][n][3] * rs); *(u32x2*)(zr + n * 16) = w; }
        }
    }
}

__device__ __forceinline__ void phase0_ssm(const Params& P, int bid, int nblk, int tid) {
    for (int i = bid * NTHR + tid; i < 2048; i += nblk * NTHR) {
        const int g = i >> 6;
        const double lr = (double)P.a_re[i], li = (double)P.a_im[i], step = exp((double)P.log_step[g]);
        const double mag = exp(lr * step), ar = mag * cos(li * step), ai = mag * sin(li * step);
        const double den = lr * lr + li * li, nr = ar - 1.0, ni = ai;
        const double qr = (nr * lr + ni * li) / den, qi = (ni * lr - nr * li) / den;
        P.abar[2 * i] = (float)ar; P.abar[2 * i + 1] = (float)ai;
        const double m64 = exp(64.0 * lr * step), m128 = exp(128.0 * lr * step);
        P.a64[2 * i] = (float)(m64 * cos(64.0 * li * step)); P.a64[2 * i + 1] = (float)(m64 * sin(64.0 * li * step));
        P.a128[2 * i] = (float)(m128 * cos(128.0 * li * step)); P.a128[2 * i + 1] = (float)(m128 * sin(128.0 * li * step));
        const int p = i & 63;
        for (int h = 0; h < 16; ++h) {
            const double br = (double)P.b_re[i * 16 + h], bi = (double)P.b_im[i * 16 + h];
            P.bbT[((size_t)g * 128 + p) * 16 + h] = f2bf((float)(qr * br - qi * bi));
            P.bbT[((size_t)g * 128 + 64 + p) * 16 + h] = f2bf((float)(qr * bi + qi * br));
        }
    }
    for (int i = bid * NTHR + tid; i < 32 * 16 * 160; i += nblk * NTHR) {
        const int k = i % 160, gh = i / 160, h = gh & 15;
        float v = 0.f;
        if (k < 64) v = P.c_re[gh * 64 + k]; else if (k < 128) v = -P.c_im[gh * 64 + k - 64]; else if (k - 128 == h) v = P.ssm_d[gh];
        P.cmT[i] = f2bf(v);
    }
}

struct SsmGroup { bf16x8 bop[4]; float ar[2], ai[2]; };
__device__ __forceinline__ void ssm_load_group(const Params& P, int g, int lane, SsmGroup& G) {
#pragma unroll
    for (int cb = 0; cb < 4; ++cb) G.bop[cb] = *(const bf16x8*)(P.bbT + ((size_t)g * 128 + 32 * cb + (lane & 31)) * 16 + 8 * (lane >> 5));
#pragma unroll
    for (int sp = 0; sp < 2; ++sp) { const int s = g * 64 + 32 * sp + (lane & 31); G.ar[sp] = P.abar[2 * s]; G.ai[sp] = P.abar[2 * s + 1]; }
}
__device__ __forceinline__ int ssm_row_token(int lane, int j) { const int r = lane & 31; return 64 * ((r >> 2) & 1) + 16 * j + (r & 3) + 4 * (r >> 3); }

__device__ __forceinline__ void phaseA2(const Params& P, int bid, int nblk, int tid) {
    const int wid = tid >> 6, lane = tid & 63;
    for (int c = bid; c < 256; c += nblk) {
        for (int gi = 0; gi < 4; ++gi) {
            const int g = wid * 4 + gi;
            SsmGroup G; ssm_load_group(P, g, lane, G);
            float xr[2] = {0.f, 0.f}, xi[2] = {0.f, 0.f};
#pragma unroll 1
            for (int j = 0; j < 4; ++j) {
                const int tok = c * 128 + ssm_row_token(lane, j);
                const bf16x8 aop = *(const bf16x8*)(P.z + (size_t)tok * DM + 512 + 16 * g + 8 * (lane >> 5));
                f32x16 bu[4];
#pragma unroll
                for (int cb = 0; cb < 4; ++cb) { f32x16 zz; for (int q = 0; q < 16; ++q) zz[q] = 0.f; bu[cb] = __builtin_amdgcn_mfma_f32_32x32x16_bf16(aop, G.bop[cb], zz, 0, 0, 0); }
#pragma unroll
                for (int i = 0; i < 16; ++i)
#pragma unroll
                    for (int sp = 0; sp < 2; ++sp) {
                        const float nxr = G.ar[sp] * xr[sp] - G.ai[sp] * xi[sp] + bu[sp][i];
                        const float nxi = G.ar[sp] * xi[sp] + G.ai[sp] * xr[sp] + bu[2 + sp][i];
                        xr[sp] = nxr; xi[sp] = nxi;
                    }
            }
#pragma unroll
            for (int sp = 0; sp < 2; ++sp) {
                const float s1r = __shfl(xr[sp], (lane & 31) + 32), s1i = __shfl(xi[sp], (lane & 31) + 32);
                if (lane < 32) {
                    const int s = g * 64 + 32 * sp + lane;
                    const float pr = P.a64[2 * s], pi = P.a64[2 * s + 1];
                    const size_t o = ((size_t)c * 2048 + s) * 2;
                    P.send0[o] = xr[sp]; P.send0[o + 1] = xi[sp];
                    P.send128[o] = pr * xr[sp] - pi * xi[sp] + s1r; P.send128[o + 1] = pr * xi[sp] + pi * xr[sp] + s1i;
                }
            }
        }
    }
}

#define XA_STRIDE 336
__device__ __forceinline__ float gelu_tanh(float y) { const float a = 1.5957691216057308f * (y + 0.044715f * y * y * y); return y / (1.0f + __expf(-a)); }

__device__ __forceinline__ void phaseB_ssm(const Params& P, LAS unsigned char* lds, int c, int tid) {
    const int wid = tid >> 6, lane = tid & 63;
    LAS float* carry = (LAS float*)(lds + MISC_OFF);
    {
        const int c0 = c & ~63;
        f32x4 cr0 = {0.f, 0.f, 0.f, 0.f}, cr1 = {0.f, 0.f, 0.f, 0.f};
        const f32x4 p0 = *(const f32x4*)(P.a128 + 8 * tid), p1 = *(const f32x4*)(P.a128 + 8 * tid + 4);
        for (int cc = c0; cc < c; ++cc) {
            const f32x4 s0 = *(const f32x4*)(P.send128 + (size_t)cc * 4096 + 8 * tid), s1 = *(const f32x4*)(P.send128 + (size_t)cc * 4096 + 8 * tid + 4);
            f32x4 n0, n1;
            n0[0] = p0[0] * cr0[0] - p0[1] * cr0[1] + s0[0]; n0[1] = p0[0] * cr0[1] + p0[1] * cr0[0] + s0[1];
            n0[2] = p0[2] * cr0[2] - p0[3] * cr0[3] + s0[2]; n0[3] = p0[2] * cr0[3] + p0[3] * cr0[2] + s0[3];
            n1[0] = p1[0] * cr1[0] - p1[1] * cr1[1] + s1[0]; n1[1] = p1[0] * cr1[1] + p1[1] * cr1[0] + s1[1];
            n1[2] = p1[2] * cr1[2] - p1[3] * cr1[3] + s1[2]; n1[3] = p1[2] * cr1[3] + p1[3] * cr1[2] + s1[3];
            cr0 = n0; cr1 = n1;
        }
        *(LAS f32x4*)(carry + 8 * tid) = cr0; *(LAS f32x4*)(carry + 8 * tid + 4) = cr1;
    }
    LAS unsigned char* XA = lds + wid * (32 * XA_STRIDE);
    if (lane < 32) { const u32x4 zz = {0u, 0u, 0u, 0u}; *(LAS u32x4*)(XA + lane * XA_STRIDE + 288) = zz; *(LAS u32x4*)(XA + lane * XA_STRIDE + 304) = zz; }
    __syncthreads();
    for (int gi = 0; gi < 4; ++gi) {
        const int g = wid * 4 + gi;
        SsmGroup G; ssm_load_group(P, g, lane, G);
        bf16x8 cf[5];
#pragma unroll
        for (int ks = 0; ks < 5; ++ks) cf[ks] = *(const bf16x8*)(P.cmT + ((size_t)g * 16 + (lane & 15)) * 160 + 32 * ks + 8 * (lane >> 4));
        float xr[2], xi[2];
#pragma unroll
        for (int sp = 0; sp < 2; ++sp) {
            const int s = g * 64 + 32 * sp + (lane & 31);
            const float c0r = carry[2 * s], c0i = carry[2 * s + 1];
            if (lane < 32) { xr[sp] = c0r; xi[sp] = c0i; }
            else { const float pr = P.a64[2 * s], pi = P.a64[2 * s + 1]; const size_t o = ((size_t)c * 2048 + s) * 2;
                   xr[sp] = pr * c0r - pi * c0i + P.send0[o]; xi[sp] = pr * c0i + pi * c0r + P.send0[o + 1]; }
        }
#pragma unroll 1
        for (int j = 0; j < 4; ++j) {
            const int trow = ssm_row_token(lane, j);
            const bf16x8 aop = *(const bf16x8*)(P.z + (size_t)(c * 128 + trow) * DM + 512 + 16 * g + 8 * (lane >> 5));
            f32x16 bu[4];
#pragma unroll
            for (int cb = 0; cb < 4; ++cb) { f32x16 zz; for (int q = 0; q < 16; ++q) zz[q] = 0.f; bu[cb] = __builtin_amdgcn_mfma_f32_32x32x16_bf16(aop, G.bop[cb], zz, 0, 0, 0); }
            { const int r = lane & 31, xrow = 16 * ((r >> 2) & 1) + (r & 3) + 4 * (r >> 3); *(LAS bf16x8*)(XA + xrow * XA_STRIDE + 256 + 16 * (lane >> 5)) = aop; }
            const bool odd = lane & 1;
            LAS unsigned char* xw = XA + (16 * (lane >> 5)) * XA_STRIDE + 2 * ((lane & 31) & ~1) + (odd ? 128 : 0);
#pragma unroll
            for (int i = 0; i < 16; ++i) {
#pragma unroll
                for (int sp = 0; sp < 2; ++sp) {
                    const float nxr = G.ar[sp] * xr[sp] - G.ai[sp] * xi[sp] + bu[sp][i];
                    const float nxi = G.ar[sp] * xi[sp] + G.ai[sp] * xr[sp] + bu[2 + sp][i];
                    xr[sp] = nxr; xi[sp] = nxi;
                    const float snd = odd ? nxr : nxi;
                    const float rcv = __uint_as_float(__builtin_amdgcn_update_dpp(0u, __float_as_uint(snd), 0xB1, 0xF, 0xF, false));
                    const unsigned w = odd ? cvt_pk_bf16(rcv, nxi) : cvt_pk_bf16(nxr, rcv);
                    *(LAS unsigned*)(xw + i * XA_STRIDE + 64 * sp) = w;
                }
            }
            asm volatile("s_waitcnt lgkmcnt(0)" ::: "memory");
#pragma unroll
            for (int rg = 0; rg < 2; ++rg) {
                f32x4 ay = {0.f, 0.f, 0.f, 0.f};
#pragma unroll
                for (int ks = 0; ks < 5; ++ks) {
                    const bf16x8 xf = *(const LAS bf16x8*)(XA + (16 * rg + (lane & 15)) * XA_STRIDE + 64 * ks + 16 * (lane >> 4));
                    ay = __builtin_amdgcn_mfma_f32_16x16x32_bf16(cf[ks], xf, ay, 0, 0, 0);
                }
                const int tok = c * 128 + 64 * rg + 16 * j + (lane & 15);
                u32x2 w; w.x = cvt_pk_bf16(gelu_tanh(ay[0]), gelu_tanh(ay[1])); w.y = cvt_pk_bf16(gelu_tanh(ay[2]), gelu_tanh(ay[3]));
                *(u32x2*)(P.ybuf + (size_t)tok * 512 + 16 * g + 4 * (lane >> 4)) = w;
            }
            asm volatile("s_waitcnt lgkmcnt(0)" ::: "memory");
        }
    }
}

__device__ __forceinline__ void phase0_weights(const Params& P, int bid, int nblk, int tid, LAS float* tl) {
    for (int job = bid; job < 64 + 256 + 2048 + 1024; job += nblk) {
        if (job < 64) {
            const int n0 = (job >> 3) * 64, k0 = (job & 7) * 64;
            tr_tile([&](int k, int n) { return P.glu_w[(size_t)(k0 + k) * 512 + n0 + n]; }, P.gluT + (size_t)n0 * 512 + k0, 512, tl, tid);
        } else if (job < 320) {
            const int j = job - 64, n0 = (j >> 4) * 64, k0 = (j & 15) * 64;
            tr_tile([&](int k, int n) { return P.w_out[(size_t)(k0 + k) * DM + n0 + n]; }, P.w_outT + (size_t)n0 * DM + k0, DM, tl, tid);
        } else if (job < 320 + 2048) {
            const int j = job - 320, kt = j & 15, wc = (j >> 4) & 3, ch = (j >> 6) & 1, e = j >> 7, k0 = kt * 64, f0 = 128 * ch + 32 * wc;
            const float* G = P.wg + (size_t)e * DM * 256; const float* U = P.wu + (size_t)e * DM * 256;
            tr_tile([&](int k, int n) { const float* S = (n < 32) ? G : U; return P.norm_ffn[k0 + k] * S[(size_t)(k0 + k) * 256 + f0 + (n & 31)]; },
                    P.wguT + ((size_t)((e * 2 + ch) * 256 + wc * 64)) * DM + k0, DM, tl, tid);
        } else {
            const int j = job - 320 - 2048, ft = j & 3, nt = (j >> 2) & 15, e = j >> 6, f0 = ft * 64, n0 = nt * 64;
            const float* Dn = P.wd + (size_t)e * 256 * DM;
            tr_tile([&](int k, int n) { return Dn[(size_t)(f0 + k) * DM + n0 + n]; }, P.wdT + ((size_t)e * DM + n0) * 256 + f0, 256, tl, tid);
        }
    }
    for (int i = bid * NTHR + tid; i < 32 * DM; i += nblk * NTHR) {
        const int j = i >> 10, k = i & 1023; float v = 0.f;
        if (j < 4) v = P.norm_ffn[k] * P.rc_w[k * 4 + j]; else if (j < 20) v = P.norm_ffn[k] * P.rf_w[k * 16 + j - 4];
        P.wrT[i] = f2bf(v);
    }
}

__device__ __forceinline__ void phaseB_pool(const Params& P, int c, int tid) {
    const int ch = tid, w = 2 << (ch >> 7), t0 = c * 128, pos0 = t0 & (SEQ - 1);
    const bf16_t* zc = P.z + ch;
    float S = 0.f;
    { const int nb = pos0 < w ? pos0 : w; for (int j = 1; j <= nb; ++j) S += bf2f(zc[(size_t)(t0 - j) * DM]); }
    const float inv_w = 1.0f / (float)w;
    for (int i = 0; i < 128; ++i) {
        const int t = t0 + i, pos = pos0 + i;
        const float zt = bf2f(zc[(size_t)t * DM]);
        S += zt;
        if (pos >= w) S -= bf2f(zc[(size_t)(t - w) * DM]);
        const float inv = (pos + 1 < w) ? 1.0f / (float)(pos + 1) : inv_w;
        P.ycat[(size_t)t * DM + ch] = f2bf(S * inv - zt);
    }
}

__device__ __forceinline__ void phaseB_glu(const Params& P, LAS unsigned char* lds, int c, int tid) {
    const int wid = __builtin_amdgcn_readfirstlane(tid >> 6), lane = tid & 63, wr = wid >> 2, wc = wid & 3, fr = lane & 15, fq = lane >> 4;
#pragma unroll 1
    for (int nt = 0; nt < 2; ++nt) {
        StagePtrs sp; sp.ksplit = 1 << 30; sp.bdelta = 0;
#pragma unroll
        for (int j = 0; j < 2; ++j) { const int r = stage_row_a(wid, lane, j); sp.a[j] = (const char*)(P.ybuf + (size_t)(c * 128 + r) * 512) + stage_chunk_off(r, lane); }
#pragma unroll
        for (int j = 0; j < 4; ++j) { const int r = stage_row_b(wid, lane, j); sp.b[j] = (const char*)(P.gluT + (size_t)(nt * 256 + r) * 512) + stage_chunk_off(r, lane); }
        f32x4 acc[4][4]; acc_zero(acc);
        gemm_core(lds, sp, 512 / 64, acc, wid, wr, wc, lane);
#pragma unroll
        for (int m = 0; m < 4; ++m) {
            const int row = c * 128 + wr * 64 + m * 16 + fr;
#pragma unroll
            for (int n = 0; n < 4; ++n) {
                const int col = nt * 256 + wc * 64 + n * 16 + 4 * fq;
                const f32x4 b = *(const f32x4*)(P.glu_b + col);
                const u32x2 yw = *(const u32x2*)(P.ybuf + (size_t)row * 512 + col);
                const float y0 = bflo(yw.x), y1 = bfhi(yw.x), y2 = bflo(yw.y), y3 = bfhi(yw.y);
                u32x2 w;
                w.x = cvt_pk_bf16(y0 / (1.0f + __expf(-(acc[m][n][0] + b[0]))), y1 / (1.0f + __expf(-(acc[m][n][1] + b[1]))));
                w.y = cvt_pk_bf16(y2 / (1.0f + __expf(-(acc[m][n][2] + b[2]))), y3 / (1.0f + __expf(-(acc[m][n][3] + b[3]))));
                *(u32x2*)(P.ycat + (size_t)row * DM + 512 + col) = w;
            }
        }
    }
}

__device__ __forceinline__ void phaseB_wout(const Params& P, LAS unsigned char* lds, int c, int tid) {
    const int wid = __builtin_amdgcn_readfirstlane(tid >> 6), lane = tid & 63, wr = wid >> 2, wc = wid & 3, fr = lane & 15, fq = lane >> 4;
    LAS float* rowss = (LAS float*)(lds + MISC_OFF);
    LAS float* sspart = (LAS float*)(lds + MISC_OFF + 1024);
#pragma unroll 1
    for (int nt = 0; nt < 4; ++nt) {
        StagePtrs sp; sp.ksplit = 1 << 30; sp.bdelta = 0;
#pragma unroll
        for (int j = 0; j < 2; ++j) { const int r = stage_row_a(wid, lane, j); sp.a[j] = (const char*)(P.ycat + (size_t)(c * 128 + r) * DM) + stage_chunk_off(r, lane); }
#pragma unroll
        for (int j = 0; j < 4; ++j) { const int r = stage_row_b(wid, lane, j); sp.b[j] = (const char*)(P.w_outT + (size_t)(nt * 256 + r) * DM) + stage_chunk_off(r, lane); }
        f32x4 acc[4][4]; acc_zero(acc);
        gemm_core(lds, sp, DM / 64, acc, wid, wr, wc, lane);
#pragma unroll
        for (int m = 0; m < 4; ++m) {
            const int lrow = wr * 64 + m * 16 + fr; const size_t row = (size_t)c * 128 + lrow;
            float ss = 0.f;
#pragma unroll
            for (int n = 0; n < 4; ++n) {
                const int col = nt * 256 + wc * 64 + n * 16 + 4 * fq;
                const f32x4 xv = *(const f32x4*)(P.x + row * DM + col);
                const f32x4 v = xv + acc[m][n];
                *(f32x4*)(P.out + row * DM + col) = v;
                u32x2 w; w.x = cvt_pk_bf16(v[0], v[1]); w.y = cvt_pk_bf16(v[2], v[3]);
                *(u32x2*)(P.x1b + row * DM + col) = w;
                ss += v[0] * v[0] + v[1] * v[1] + v[2] * v[2] + v[3] * v[3];
            }
            ss += __shfl_xor(ss, 16); ss += __shfl_xor(ss, 32);
            if (fq == 0) sspart[lrow * 16 + nt * 4 + wc] = ss;
        }
    }
    asm volatile("s_waitcnt vmcnt(0)" ::: "memory");
    __syncthreads();
    if (tid < 128) { float t = 0.f;
#pragma unroll
        for (int q = 0; q < 16; ++q) t += sspart[tid * 16 + q];
        const float r = rsqrtf(t * (1.0f / DM) + EPSV); P.rstd2[c * 128 + tid] = r; rowss[tid] = r; }
    __syncthreads();
}

#define LG_OFF (MISC_OFF + 1024)
#define CNT_OFF (MISC_OFF + 1024 + 10240)
__device__ __forceinline__ void phaseB_router(const Params& P, LAS unsigned char* lds, int c, int tid) {
    const int wid = tid >> 6, lane = tid & 63, l15 = lane & 15, fq = lane >> 4;
    LAS float* rowss = (LAS float*)(lds + MISC_OFF);
    LAS float* lg = (LAS float*)(lds + LG_OFF);
    LAS int* lcnt = (LAS int*)(lds + CNT_OFF);
    if (tid < 48) lcnt[tid] = 0;
    {
        f32x4 a0 = {0.f, 0.f, 0.f, 0.f}, a1 = {0.f, 0.f, 0.f, 0.f};
        const bf16_t* xr = P.x1b + (size_t)(c * 128 + wid * 16 + l15) * DM + 8 * fq;
        const bf16_t* w0 = P.wrT + (size_t)l15 * DM + 8 * fq;
        const bf16_t* w1 = P.wrT + (size_t)(16 + l15) * DM + 8 * fq;
#pragma unroll 8
        for (int ks = 0; ks < 32; ++ks) {
            const bf16x8 xf = *(const bf16x8*)(xr + 32 * ks), f0 = *(const bf16x8*)(w0 + 32 * ks), f1 = *(const bf16x8*)(w1 + 32 * ks);
            a0 = __builtin_amdgcn_mfma_f32_16x16x32_bf16(f0, xf, a0, 0, 0, 0);
            a1 = __builtin_amdgcn_mfma_f32_16x16x32_bf16(f1, xf, a1, 0, 0, 0);
        }
        const int r = wid * 16 + l15;
#pragma unroll
        for (int q = 0; q < 4; ++q) lg[r * 20 + 4 * fq + q] = a0[q];
        if (fq == 0) {
#pragma unroll
            for (int q = 0; q < 4; ++q) lg[r * 20 + 16 + q] = a1[q];
        }
    }
    __syncthreads();
    int cls = 0, rank = 0; float wlo = 0.f, whi = 0.f;
    if (tid < 128) {
        const float rs = rowss[tid];
        float cl[4];
#pragma unroll
        for (int j = 0; j < 4; ++j) cl[j] = lg[tid * 20 + j] * rs + P.rc_b[j];
        int gi = 0; float mx = cl[0];
#pragma unroll
        for (int j = 1; j < 4; ++j) if (cl[j] > mx) { mx = cl[j]; gi = j; }
        float se = 0.f;
#pragma unroll
        for (int j = 0; j < 4; ++j) se += __expf(cl[j] - mx);
        const float pg = 1.0f / se;
        float f[4];
#pragma unroll
        for (int j = 0; j < 4; ++j) {
            float v = lg[tid * 20 + 4 + j] ;
            v = (gi == 1) ? lg[tid * 20 + 8 + j] : v; v = (gi == 2) ? lg[tid * 20 + 12 + j] : v; v = (gi == 3) ? lg[tid * 20 + 16 + j] : v;
            f[j] = v * rs + P.rf_b[gi * 4 + j];
        }
        int i0 = 0; float v0 = f[0];
#pragma unroll
        for (int j = 1; j < 4; ++j) if (f[j] > v0) { v0 = f[j]; i0 = j; }
        int i1 = -1; float v1 = 0.f;
#pragma unroll
        for (int j = 0; j < 4; ++j) if (j != i0 && (i1 < 0 || f[j] > v1)) { v1 = f[j]; i1 = j; }
        const float e1 = __expf(v1 - v0);
        const float wa = pg / (1.0f + e1), wb = pg * e1 / (1.0f + e1);
        const int lo = i0 < i1 ? i0 : i1, hi = i0 < i1 ? i1 : i0;
        wlo = (i0 < i1) ? wa : wb; whi = (i0 < i1) ? wb : wa;
        const int pidx = (lo == 0) ? (hi - 1) : ((lo == 1) ? (hi + 1) : 5);
        cls = gi * 6 + pidx;
        rank = __hip_atomic_fetch_add(&lcnt[cls], 1, __ATOMIC_RELAXED, __HIP_MEMORY_SCOPE_WORKGROUP);
    }
    __syncthreads();
    if (tid < 24) { const int n = lcnt[tid]; lcnt[24 + tid] = n ? (int)atomicAdd((unsigned*)P.ctl + 64 + tid, (unsigned)n) : 0; }
    __syncthreads();
    if (tid < 128) {
        const int tok = c * 128 + tid;
        P.perm[(size_t)cls * T_TOK + lcnt[24 + cls] + rank] = tok;
        P.tokw[2 * tok] = wlo; P.tokw[2 * tok + 1] = whi;
    }
}

#define C_TOK_OFF (MISC_OFF)
#define C_RS_OFF (MISC_OFF + 512)
#define C_WL_OFF (MISC_OFF + 1024)
#define C_WH_OFF (MISC_OFF + 1536)
#define C_SS_OFF (MISC_OFF + 2048)
__device__ __forceinline__ void phaseC(const Params& P, LAS unsigned char* lds, int bid, int nblk, int tid) {
    const int wid = __builtin_amdgcn_readfirstlane(tid >> 6), lane = tid & 63, wr = wid >> 2, wc = wid & 3, fr = lane & 15, fq = lane >> 4;
    LAS int* rowtok = (LAS int*)(lds + C_TOK_OFF);
    LAS float* rsv = (LAS float*)(lds + C_RS_OFF);
    LAS float* wlv = (LAS float*)(lds + C_WL_OFF);
    LAS float* whv = (LAS float*)(lds + C_WH_OFF);
    LAS float* rowss = (LAS float*)(lds + C_SS_OFF);
    const unsigned* gcnt = P.ctl + 64;
    int total = 0;
    for (int k = 0; k < 24; ++k) total += ((int)gcnt[k] + 127) >> 7;
    for (int u = bid; u < total; u += nblk) {
        int cls = 0, j = u, cnt = 0;
        for (int k = 0; k < 24; ++k) { const int n = (int)gcnt[k], t = (n + 127) >> 7; if (j < t) { cls = k; cnt = n; break; } j -= t; }
        const int nvalid = (cnt - 128 * j) < 128 ? (cnt - 128 * j) : 128;
        __syncthreads();
        if (tid < 128) {
            const int r = tid < nvalid ? tid : nvalid - 1;
            const int tok = P.perm[(size_t)cls * T_TOK + 128 * j + r];
            rowtok[tid] = tok; rsv[tid] = P.rstd2[tok]; wlv[tid] = P.tokw[2 * tok]; whv[tid] = P.tokw[2 * tok + 1];
        }
        __syncthreads();
        const int gi = cls / 6, pidx = cls - gi * 6;
        const int lo = pidx < 3 ? 0 : (pidx < 5 ? 1 : 2), hi = pidx < 3 ? pidx + 1 : (pidx < 5 ? pidx - 1 : 3);
        const int e_lo = gi * 4 + lo, e_hi = gi * 4 + hi;
        bf16_t* hid = P.hid + (size_t)u * 128 * 512;
#pragma unroll 1
        for (int s = 0; s < 2; ++s) {
            const int e = s ? e_hi : e_lo;
#pragma unroll 1
            for (int ch = 0; ch < 2; ++ch) {
                StagePtrs sp; sp.ksplit = 1 << 30; sp.bdelta = 0;
#pragma unroll
                for (int q = 0; q < 2; ++q) { const int r = stage_row_a(wid, lane, q); sp.a[q] = (const char*)(P.x1b + (size_t)rowtok[r] * DM) + stage_chunk_off(r, lane); }
#pragma unroll
                for (int q = 0; q < 4; ++q) { const int r = stage_row_b(wid, lane, q); sp.b[q] = (const char*)(P.wguT + ((size_t)(e * 2 + ch) * 256 + r) * DM) + stage_chunk_off(r, lane); }
                f32x4 acc[4][4]; acc_zero(acc);
                gemm_core(lds, sp, DM / 64, acc, wid, wr, wc, lane);
#pragma unroll
                for (int m = 0; m < 4; ++m) {
                    const int r = wr * 64 + m * 16 + fr; const float rs = rsv[r], wsel = s ? whv[r] : wlv[r];
#pragma unroll
                    for (int n = 0; n < 2; ++n) {
                        float h[4];
#pragma unroll
                        for (int q = 0; q < 4; ++q) { const float g = acc[m][n][q] * rs, uu = acc[m][n + 2][q] * rs; h[q] = g / (1.0f + __expf(-g)) * uu * wsel; }
                        u32x2 w; w.x = cvt_pk_bf16(h[0], h[1]); w.y = cvt_pk_bf16(h[2], h[3]);
                        *(u32x2*)(hid + (size_t)r * 512 + 256 * s + 128 * ch + 32 * wc + 16 * n + 4 * fq) = w;
                    }
                    asm volatile("" ::: "memory");
                }
            }
        }
#pragma unroll 1
        for (int nt = 0; nt < 4; ++nt) {
            StagePtrs sp; sp.ksplit = 4; sp.bdelta = (long)(e_hi - e_lo) * DM * 256 * 2;
#pragma unroll
            for (int q = 0; q < 2; ++q) { const int r = stage_row_a(wid, lane, q); sp.a[q] = (const char*)(hid + (size_t)r * 512) + stage_chunk_off(r, lane); }
#pragma unroll
            for (int q = 0; q < 4; ++q) { const int r = stage_row_b(wid, lane, q); sp.b[q] = (const char*)(P.wdT + ((size_t)e_lo * DM + nt * 256 + r) * 256) + stage_chunk_off(r, lane); }
            f32x4 acc[4][4]; acc_zero(acc);
            gemm_core(lds, sp, 8, acc, wid, wr, wc, lane);
#pragma unroll
            for (int m = 0; m < 4; ++m) {
                const int r = wr * 64 + m * 16 + fr;
                float ss = 0.f;
                if (r < nvalid) {
                    float* orow = P.out + (size_t)rowtok[r] * DM + nt * 256 + wc * 64 + 4 * fq;
#pragma unroll
                    for (int n = 0; n < 4; ++n) { const f32x4 v = *(const f32x4*)(orow + n * 16) + acc[m][n]; *(f32x4*)(orow + n * 16) = v; ss += v[0] * v[0] + v[1] * v[1] + v[2] * v[2] + v[3] * v[3]; }
                }
                ss += __shfl_xor(ss, 16); ss += __shfl_xor(ss, 32);
                if (fq == 0) rowss[r * 16 + nt * 4 + wc] = ss;
                asm volatile("" ::: "memory");
            }
        }
        __syncthreads();
#pragma unroll 1
        for (int nt = 0; nt < 4; ++nt)
#pragma unroll
            for (int m = 0; m < 4; ++m) {
                const int r = wr * 64 + m * 16 + fr;
                if (r < nvalid) {
                    float tsum = 0.f;
#pragma unroll
                    for (int q = 0; q < 16; ++q) tsum += rowss[r * 16 + q];
                    const float rs3 = rsqrtf(tsum * (1.0f / DM) + EPSV);
                    float* orow = P.out + (size_t)rowtok[r] * DM + nt * 256 + wc * 64 + 4 * fq;
#pragma unroll
                    for (int n = 0; n < 4; ++n) { const f32x4 g = *(const f32x4*)(P.norm_final + nt * 256 + wc * 64 + 4 * fq + n * 16); f32x4 v = *(const f32x4*)(orow + n * 16); v = v * rs3 * g; *(f32x4*)(orow + n * 16) = v; }
                }
                asm volatile("" ::: "memory");
            }
    }
}

static void fill_params(Params& P, void* const* d_in, void* d_out, void* d_ws) {
    memset(&P, 0, sizeof(P));
    P.x = (const float*)d_in[0]; P.norm_mix = (const float*)d_in[1]; P.w_in = (const float*)d_in[2]; P.pool_w = (const float*)d_in[3]; P.pool_scale = (const float*)d_in[4];
    P.a_re = (const float*)d_in[5]; P.a_im = (const float*)d_in[6]; P.log_step = (const float*)d_in[7]; P.b_re = (const float*)d_in[8]; P.b_im = (const float*)d_in[9];
    P.c_re = (const float*)d_in[10]; P.c_im = (const float*)d_in[11]; P.ssm_d = (const float*)d_in[12]; P.glu_w = (const float*)d_in[13]; P.glu_b = (const float*)d_in[14];
    P.w_out = (const float*)d_in[15]; P.norm_ffn = (const float*)d_in[16]; P.rc_w = (const float*)d_in[17]; P.rc_b = (const float*)d_in[18]; P.rf_w = (const float*)d_in[19]; P.rf_b = (const float*)d_in[20];
    P.wg = (const float*)d_in[21]; P.wu = (const float*)d_in[22]; P.wd = (const float*)d_in[23]; P.norm_final = (const float*)d_in[24];
    P.out = (float*)d_out;
    char* ws = (char*)d_ws; const size_t MB = 1u << 20;
    P.ctl = (unsigned*)ws;
    P.rstd1 = (float*)(ws + 1 * MB); P.rstd2 = (float*)(ws + 1 * MB + 131072); P.tokw = (float*)(ws + 1 * MB + 262144);
    P.abar = (float*)(ws + 2 * MB); P.a64 = (float*)(ws + 2 * MB + 16384); P.a128 = (float*)(ws + 2 * MB + 32768); P.bbT = (bf16_t*)(ws + 2 * MB + 65536); P.cmT = (bf16_t*)(ws + 2 * MB + 65536 + 131072);
    P.wrT = (bf16_t*)(ws + 3 * MB);
    P.send0 = (float*)(ws + 4 * MB); P.send128 = (float*)(ws + 8 * MB);
    P.perm = (int*)(ws + 12 * MB);
    P.w_inT = (bf16_t*)(ws + 16 * MB); P.gluT = (bf16_t*)(ws + 18 * MB); P.w_outT = (bf16_t*)(ws + 19 * MB);
    P.wguT = (bf16_t*)(ws + 24 * MB); P.wdT = (bf16_t*)(ws + 40 * MB);
    P.hid = (bf16_t*)(ws + 48 * MB);
    P.xb = (bf16_t*)(ws + 96 * MB); P.z = (bf16_t*)(ws + 160 * MB); P.ycat = (bf16_t*)(ws + 224 * MB); P.x1b = (bf16_t*)(ws + 288 * MB); P.ybuf = (bf16_t*)(ws + 352 * MB);
}
#define CTL_BYTES 65536

__global__ void __launch_bounds__(NTHR) k_f_prep(Params P) {
    extern __shared__ __attribute__((aligned(16))) unsigned char lds_raw[];
    LAS unsigned char* lds = (LAS unsigned char*)lds_raw;
    phase0_x(P, blockIdx.x, gridDim.x, threadIdx.x);
    phase0_w_in(P, blockIdx.x, gridDim.x, threadIdx.x, (LAS float*)lds);
    phase0_ssm(P, blockIdx.x, gridDim.x, threadIdx.x);
    phase0_weights(P, blockIdx.x, gridDim.x, threadIdx.x, (LAS float*)lds);
}
__global__ void __launch_bounds__(NTHR) k_f_gemm1(Params P) {
    extern __shared__ __attribute__((aligned(16))) unsigned char lds_raw[];
    phaseA(P, (LAS unsigned char*)lds_raw, blockIdx.x, gridDim.x, threadIdx.x);
}
__global__ void __launch_bounds__(NTHR) k_f_a2(Params P) { phaseA2(P, blockIdx.x, gridDim.x, threadIdx.x); }
__global__ void __launch_bounds__(NTHR) k_f_b(Params P) {
    extern __shared__ __attribute__((aligned(16))) unsigned char lds_raw[];
    LAS unsigned char* lds = (LAS unsigned char*)lds_raw;
    const int c = blockIdx.x;
    phaseB_ssm(P, lds, c, threadIdx.x);
    __syncthreads();
    phaseB_pool(P, c, threadIdx.x);
    phaseB_glu(P, lds, c, threadIdx.x);
    phaseB_wout(P, lds, c, threadIdx.x);
    phaseB_router(P, lds, c, threadIdx.x);
}
__global__ void __launch_bounds__(NTHR) k_f_c(Params P) {
    extern __shared__ __attribute__((aligned(16))) unsigned char lds_raw[];
    phaseC(P, (LAS unsigned char*)lds_raw, blockIdx.x, gridDim.x, threadIdx.x);
}
extern "C" void kernel_launch(void* const* d_in, const int* in_sizes, int n_in, void* d_out, int out_size, void* d_ws, size_t ws_size, hipStream_t stream) {
    Params P; fill_params(P, d_in, d_out, d_ws);
    static bool attr_done = false;
    if (!attr_done) {
        (void)hipFuncSetAttribute((const void*)k_f_prep, hipFuncAttributeMaxDynamicSharedMemorySize, LDS_BYTES); (void)hipFuncSetAttribute((const void*)k_f_gemm1, hipFuncAttributeMaxDynamicSharedMemorySize, LDS_BYTES);
        (void)hipFuncSetAttribute((const void*)k_f_b, hipFuncAttributeMaxDynamicSharedMemorySize, LDS_BYTES); (void)hipFuncSetAttribute((const void*)k_f_c, hipFuncAttributeMaxDynamicSharedMemorySize, LDS_BYTES); attr_done = true; }
    (void)hipMemsetAsync(d_ws, 0, CTL_BYTES, stream);
    k_f_prep<<<256, NTHR, LDS_BYTES, stream>>>(P);
    k_f_gemm1<<<256, NTHR, LDS_BYTES, stream>>>(P);
    k_f_a2<<<256, NTHR, 0, stream>>>(P);
    k_f_b<<<256, NTHR, LDS_BYTES, stream>>>(P);
    k_f_c<<<256, NTHR, LDS_BYTES, stream>>>(P);
}
```

```cpp
#include <hip/hip_runtime.h>
#include <stdint.h>
#include <string.h>
#include <stdio.h>
#define T_TOK 32768
#define SEQ 8192
#define DM 1024
#define EPSV 1e-6f

#define LAS __attribute__((address_space(3)))
typedef unsigned short bf16_t;
typedef short bf16x8 __attribute__((ext_vector_type(8)));
typedef float f32x4 __attribute__((ext_vector_type(4)));
typedef float f32x16 __attribute__((ext_vector_type(16)));
typedef unsigned u32x2 __attribute__((ext_vector_type(2)));
typedef unsigned u32x4 __attribute__((ext_vector_type(4)));

#define NTHR 512
#define LDS_BYTES 163840
#define STAGE_B 49152
#define MISC_OFF (3 * STAGE_B)

__device__ __forceinline__ unsigned cvt_pk_bf16(float lo, float hi) { unsigned r; asm("v_cvt_pk_bf16_f32 %0, %1, %2" : "=v"(r) : "v"(lo), "v"(hi)); return r; }
__device__ __forceinline__ bf16_t f2bf(float f) { return (bf16_t)(cvt_pk_bf16(f, 0.f) & 0xffffu); }
__device__ __forceinline__ float bf2f(bf16_t h) { return __uint_as_float(((unsigned)h) << 16); }
__device__ __forceinline__ float bflo(unsigned w) { return __uint_as_float(w << 16); }
__device__ __forceinline__ float bfhi(unsigned w) { return __uint_as_float(w & 0xffff0000u); }

struct StagePtrs { const char* a[3]; const char* b[4]; long bdelta; int ksplit; int kt0; int nkt; };

__device__ __forceinline__ int stage_row_a(int wid, int lane, int i) { return (i < 2 ? (wid * 2 + i) * 8 : 128 + wid * 8) + (lane >> 3); }
__device__ __forceinline__ int stage_row_b(int wid, int lane, int i) { return (wid * 4 + i) * 8 + (lane >> 3); }
__device__ __forceinline__ int stage_chunk_off(int row, int lane) { return (((lane & 7) ^ ((row >> 1) & 7)) << 4); }

template <int MF0>
__device__ __forceinline__ void stage_issue(LAS unsigned char* lds, int s, const StagePtrs& sp, int kt_, int wid) {
    constexpr int ABYTES = (64 + 16 * MF0) * 128, SB = ABYTES + 32768;
    LAS unsigned char* base = lds + s * SB;
    int kt = kt_ + sp.kt0; kt = (kt >= sp.nkt) ? kt - sp.nkt : kt;
#pragma unroll
    for (int i = 0; i < 2; ++i) __builtin_amdgcn_global_load_lds((const unsigned*)(sp.a[i] + (size_t)kt * 128), (LAS unsigned*)(base + (wid * 2 + i) * 1024), 16, 0, 0);
    if (MF0 == 5 && wid < 2) __builtin_amdgcn_global_load_lds((const unsigned*)(sp.a[2] + (size_t)kt * 128), (LAS unsigned*)(base + (16 + wid) * 1024), 16, 0, 0);
    const long bofs = (kt < sp.ksplit) ? (long)kt * 128 : (long)(kt - sp.ksplit) * 128 + sp.bdelta;
#pragma unroll
    for (int i = 0; i < 4; ++i) __builtin_amdgcn_global_load_lds((const unsigned*)(sp.b[i] + bofs), (LAS unsigned*)(base + ABYTES + (wid * 4 + i) * 1024), 16, 0, 0);
}

template <int MF0>
__device__ __forceinline__ void gemm_core(LAS unsigned char* lds, const StagePtrs& sp, int nkt, f32x4 (&acc)[MF0][4], int wid, int wr, int wc, int lane, bool drain = true) {
    constexpr int ABYTES = (64 + 16 * MF0) * 128, SB = ABYTES + 32768;
    const int fr = lane & 15, fq = lane >> 4, sw = fr >> 1;
    const int offk0 = fr * 128 + ((fq ^ sw) << 4), offk1 = fr * 128 + (((4 + fq) ^ sw) << 4);
    const int aoff = wr * (MF0 * 2048), boff = ABYTES + wc * 8192;
    const bool extra = (MF0 == 5) && (wid < 2);
#define GC_BAR() do { asm volatile("s_waitcnt lgkmcnt(0)" ::: "memory"); __builtin_amdgcn_s_barrier(); asm volatile("" ::: "memory"); } while (0)
#define GC_WAIT1() do { if (extra) asm volatile("s_waitcnt vmcnt(7)" ::: "memory"); else asm volatile("s_waitcnt vmcnt(6)" ::: "memory"); } while (0)
    if (drain) asm volatile("s_waitcnt vmcnt(0)" ::: "memory");
    GC_BAR();
    stage_issue<MF0>(lds, 0, sp, 0, wid);
    if (nkt > 1) stage_issue<MF0>(lds, 1, sp, 1, wid);
    if (nkt > 1 && drain) GC_WAIT1(); else asm volatile("s_waitcnt vmcnt(0)" ::: "memory");
    GC_BAR();
    if (wr == 1) GC_BAR();
    int s = 0;
#pragma unroll 1
    for (int kt = 0; kt < nkt; ++kt) {
        if (kt + 2 < nkt) { const int s2 = (s >= 1) ? s - 1 : 2; stage_issue<MF0>(lds, s2, sp, kt + 2, wid); }
        const LAS unsigned char* st = lds + s * SB;
        bf16x8 af[2][MF0], bfr[2][4];
#pragma unroll
        for (int ks = 0; ks < 2; ++ks) {
            const int ok = ks ? offk1 : offk0;
#pragma unroll
            for (int m = 0; m < MF0; ++m) if (m < 4 || wr == 0) af[ks][m] = *(const LAS bf16x8*)(st + aoff + m * 2048 + ok);
#pragma unroll
            for (int n = 0; n < 4; ++n) bfr[ks][n] = *(const LAS bf16x8*)(st + boff + n * 2048 + ok);
        }
        if (kt + 2 < nkt) GC_WAIT1(); else asm volatile("s_waitcnt vmcnt(0)" ::: "memory");
        GC_BAR();
        __builtin_amdgcn_s_setprio(1);
#pragma unroll
        for (int ks = 0; ks < 2; ++ks)
#pragma unroll
            for (int m = 0; m < MF0; ++m) if (m < 4 || wr == 0) {
#pragma unroll
                for (int n = 0; n < 4; ++n) acc[m][n] = __builtin_amdgcn_mfma_f32_16x16x32_bf16(bfr[ks][n], af[ks][m], acc[m][n], 0, 0, 0); }
        __builtin_amdgcn_s_setprio(0);
        GC_BAR();
        s = (s == 2) ? 0 : s + 1;
    }
    if (wr == 0) GC_BAR();
#undef GC_BAR
#undef GC_WAIT1
}
template <int MF0>
__device__ __forceinline__ void acc_zero(f32x4 (&acc)[MF0][4]) {
#pragma unroll
    for (int m = 0; m < MF0; ++m)
#pragma unroll
        for (int n = 0; n < 4; ++n) acc[m][n] = (f32x4){0.f, 0.f, 0.f, 0.f};
}


#define XB_TMO      128
#define XB_XCNT(j)  (256  + 64 * (j))
#define XB_XSUB(j)  (1280 + 64 * (j))
#define XB_XGEN(j)  (2304 + 64 * (j))
#define XB_TOP      3328
#define XB_TOPGEN   3392
#define XCD_BAR_WORDS 3456
#define XB_SPIN_CAP (1u << 18)

__device__ __forceinline__ unsigned xb_ld(unsigned* p)              { return __hip_atomic_load(p, __ATOMIC_RELAXED, __HIP_MEMORY_SCOPE_AGENT); }
__device__ __forceinline__ unsigned xb_add(unsigned* p, unsigned v) { return __hip_atomic_fetch_add(p, v, __ATOMIC_RELAXED, __HIP_MEMORY_SCOPE_AGENT); }
__device__ __forceinline__ unsigned xb_xcc_id() { return (unsigned)__builtin_amdgcn_s_getreg((3 << 11) | 20) & 0xFu; }
#define XB_SPIN(cond, bar) do { unsigned _sp = 0; while (cond) { __builtin_amdgcn_s_sleep(1); \
    if ((++_sp & 255u) == 0u) { if (xb_ld(&(bar)[XB_TMO])) break; if (_sp > XB_SPIN_CAP) { atomicAdd(&(bar)[XB_TMO], 1u); break; } } } } while (0)

struct XcdBarrier {
    unsigned* bar; unsigned x;
    volatile LAS unsigned* st;
};

__device__ __forceinline__ XcdBarrier xcd_barrier_post(unsigned* bar, volatile LAS unsigned* st) {
    XcdBarrier b; b.bar = bar; b.x = xb_xcc_id(); b.st = st;
    if (threadIdx.x == 0) (void)xb_add(&bar[XB_XCNT(b.x)], 1u);
    return b;
}
__device__ __forceinline__ void xcd_barrier_complete(unsigned* bar, unsigned x, unsigned& nloc, unsigned& nx) {
    const unsigned G = gridDim.x * gridDim.y * gridDim.z;
    unsigned sum, cnt, mine, sp = 0u;
    for (;;) {
        sum = 0u; cnt = 0u; mine = 0u;
#pragma unroll
        for (unsigned j = 0; j < 16; ++j) { const unsigned c = xb_ld(&bar[XB_XCNT(j)]); sum += c; cnt += (c > 0u) ? 1u : 0u; mine = (j == x) ? c : mine; }
        if (sum == G) break;
        __builtin_amdgcn_s_sleep(1);
        if ((++sp & 255u) == 0u) { if (xb_ld(&bar[XB_TMO])) break; if (sp > XB_SPIN_CAP) { atomicAdd(&bar[XB_TMO], 1u); break; } }
    }
    nloc = mine > 0u ? mine : 1u; nx = cnt > 0u ? cnt : 1u;
}

__device__ __forceinline__ void xcd_barrier(const XcdBarrier& b) {
    asm volatile("s_waitcnt vmcnt(0)" ::: "memory");
    __syncthreads();
    if (threadIdx.x == 0) {
        unsigned* bar = b.bar;
        __builtin_amdgcn_s_waitcnt(0);
        unsigned nloc = b.st[0], nx = b.st[1];
        if (nloc == 0u) { xcd_barrier_complete(bar, b.x, nloc, nx); b.st[0] = nloc; b.st[1] = nx; }
        const unsigned old = xb_add(&bar[XB_XSUB(b.x)], 1u);
        const unsigned gen = old / nloc;
        if (old + 1u == (gen + 1u) * nloc) {
            __builtin_amdgcn_fence(__ATOMIC_RELEASE, "agent");
            asm volatile("s_waitcnt vmcnt(0)" ::: "memory");
            const unsigned og = xb_add(&bar[XB_TOP], 1u);
            const unsigned tg = og / nx;
            if (og + 1u == (tg + 1u) * nx) xb_add(&bar[XB_TOPGEN], 1u);
            else XB_SPIN(xb_ld(&bar[XB_TOPGEN]) == tg, bar);
            __builtin_amdgcn_fence(__ATOMIC_ACQUIRE, "agent");
            xb_add(&bar[XB_XGEN(b.x)], 1u);
            asm volatile("s_waitcnt vmcnt(0)" ::: "memory");
        } else {
            XB_SPIN(xb_ld(&bar[XB_XGEN(b.x)]) == gen, bar);
            __builtin_amdgcn_fence(__ATOMIC_ACQUIRE, "agent");
            asm volatile("s_waitcnt vmcnt(0)" ::: "memory");
        }
    }
    __syncthreads();
}


struct Params {
    const float* x; const float* norm_mix; const float* w_in; const float* pool_w; const float* pool_scale;
    const float* a_re; const float* a_im; const float* log_step; const float* b_re; const float* b_im; const float* c_re; const float* c_im; const float* ssm_d;
    const float* glu_w; const float* glu_b; const float* w_out; const float* norm_ffn; const float* rc_w; const float* rc_b; const float* rf_w; const float* rf_b;
    const float* wg; const float* wu; const float* wd; const float* norm_final;
    float* out;
    char* ws;
#define WS_MB(x) ((size_t)(x) << 20)
    __device__ __forceinline__ unsigned* ctl() const { return (unsigned*)ws; }
    __device__ __forceinline__ float* rstd1() const { return (float*)(ws + WS_MB(1)); }
    __device__ __forceinline__ float* rstd2() const { return (float*)(ws + WS_MB(1) + 131072); }
    __device__ __forceinline__ float* tokw() const { return (float*)(ws + WS_MB(1) + 262144); }
    __device__ __forceinline__ float* abar() const { return (float*)(ws + WS_MB(2)); }
    __device__ __forceinline__ float* a64() const { return (float*)(ws + WS_MB(2) + 16384); }
    __device__ __forceinline__ float* a128() const { return (float*)(ws + WS_MB(2) + 32768); }
    __device__ __forceinline__ bf16_t* bbT() const { return (bf16_t*)(ws + WS_MB(2) + 65536); }
    __device__ __forceinline__ bf16_t* cmT() const { return (bf16_t*)(ws + WS_MB(2) + 65536 + 131072); }
    __device__ __forceinline__ bf16_t* wrT() const { return (bf16_t*)(ws + WS_MB(3)); }
    __device__ __forceinline__ float* send0() const { return (float*)(ws + WS_MB(4)); }
    __device__ __forceinline__ float* send128() const { return (float*)(ws + WS_MB(8)); }
    __device__ __forceinline__ int* perm() const { return (int*)(ws + WS_MB(12)); }
    __device__ __forceinline__ bf16_t* w_inT() const { return (bf16_t*)(ws + WS_MB(16)); }
    __device__ __forceinline__ bf16_t* gluT() const { return (bf16_t*)(ws + WS_MB(18)); }
    __device__ __forceinline__ bf16_t* w_outT() const { return (bf16_t*)(ws + WS_MB(19)); }
    __device__ __forceinline__ bf16_t* wguT() const { return (bf16_t*)(ws + WS_MB(24)); }
    __device__ __forceinline__ bf16_t* wdT() const { return (bf16_t*)(ws + WS_MB(40)); }
    __device__ __forceinline__ bf16_t* hid() const { return (bf16_t*)(ws + WS_MB(48)); }
    __device__ __forceinline__ bf16_t* xb() const { return (bf16_t*)(ws + WS_MB(96)); }
    __device__ __forceinline__ bf16_t* z() const { return (bf16_t*)(ws + WS_MB(160)); }
    __device__ __forceinline__ bf16_t* ycat() const { return (bf16_t*)(ws + WS_MB(224)); }
    __device__ __forceinline__ bf16_t* x1b() const { return (bf16_t*)(ws + WS_MB(288)); }
    __device__ __forceinline__ bf16_t* ybuf() const { return (bf16_t*)(ws + WS_MB(352)); }
};

__device__ __forceinline__ void phase0_x(const Params& P, int bid, int nblk, int tid) {
    const int wave = tid >> 6, lane = tid & 63;
    for (int row = (bid * 8 + wave) * 4; row < T_TOK; row += nblk * 32) {
        f32x4 v[4][4];
#pragma unroll
        for (int r = 0; r < 4; ++r)
#pragma unroll
            for (int i = 0; i < 4; ++i) v[r][i] = __builtin_nontemporal_load((const f32x4*)(P.x + (size_t)(row + r) * DM + i * 256 + lane * 4));
        asm volatile("s_waitcnt vmcnt(0)" ::: "memory");
#pragma unroll
        for (int r = 0; r < 4; ++r) {
            float s = 0.f;
#pragma unroll
            for (int i = 0; i < 4; ++i) s += v[r][i][0] * v[r][i][0] + v[r][i][1] * v[r][i][1] + v[r][i][2] * v[r][i][2] + v[r][i][3] * v[r][i][3];
#pragma unroll
            for (int o = 32; o > 0; o >>= 1) s += __shfl_xor(s, o);
            if (lane == 0) P.rstd1()[row + r] = rsqrtf(s * (1.0f / DM) + EPSV);
            bf16_t* xo = P.xb() + (size_t)(row + r) * DM;
#pragma unroll
            for (int i = 0; i < 4; ++i) { u32x2 w; w.x = cvt_pk_bf16(v[r][i][0], v[r][i][1]); w.y = cvt_pk_bf16(v[r][i][2], v[r][i][3]); *(u32x2*)(xo + i * 256 + lane * 4) = w; }
        }
    }
}

struct TrJob { const float* sa; const float* sb; const float* scale; bf16_t* dst; int lds; int ldd; };
__device__ __forceinline__ void tr_describe(const Params& P, int job, TrJob& J) {
    if (job < 128) { const int n0 = 512 + (job >> 4) * 64, k0 = (job & 15) * 64;
        J.sa = P.w_in + (size_t)k0 * DM + n0; J.sb = J.sa + 32; J.scale = P.norm_mix + k0; J.dst = P.w_inT() + (size_t)n0 * DM + k0; J.lds = DM; J.ldd = DM; }
    else if (job < 192) { const int j = job - 128, n0 = (j >> 3) * 64, k0 = (j & 7) * 64;
        J.sa = P.glu_w + (size_t)k0 * 512 + n0; J.sb = J.sa + 32; J.scale = nullptr; J.dst = P.gluT() + (size_t)n0 * 512 + k0; J.lds = 512; J.ldd = 512; }
    else if (job < 448) { const int j = job - 192, n0 = (j >> 4) * 64, k0 = (j & 15) * 64;
        J.sa = P.w_out + (size_t)k0 * DM + n0; J.sb = J.sa + 32; J.scale = nullptr; J.dst = P.w_outT() + (size_t)n0 * DM + k0; J.lds = DM; J.ldd = DM; }
    else if (job < 2496) { const int j = job - 448, kt = j & 15, wc = (j >> 4) & 3, ch = (j >> 6) & 1, e = j >> 7, k0 = kt * 64, f0 = 128 * ch + 32 * wc;
        J.sa = P.wg + ((size_t)e * DM + k0) * 256 + f0; J.sb = P.wu + ((size_t)e * DM + k0) * 256 + f0; J.scale = P.norm_ffn + k0;
        J.dst = P.wguT() + ((size_t)((e * 2 + ch) * 256 + wc * 64)) * DM + k0; J.lds = 256; J.ldd = DM; }
    else { const int j = job - 2496, ft = j & 3, nt = (j >> 2) & 15, e = j >> 6, f0 = ft * 64, n0 = nt * 64;
        J.sa = P.wd + ((size_t)e * 256 + f0) * DM + n0; J.sb = J.sa + 32; J.scale = nullptr; J.dst = P.wdT() + ((size_t)e * DM + n0) * 256 + f0; J.lds = DM; J.ldd = 256; }
}
__device__ __forceinline__ void tr_round(const Params& P, int job0, int jstep, int njobs_end, LAS float* tl, int tid) {
    TrJob J[4]; f32x4 a[4], b[4]; float sc[4];
    const int k = tid >> 3, c8 = (tid & 7) * 8;
#pragma unroll
    for (int q = 0; q < 4; ++q) { const int job = job0 + q * jstep; if (job < njobs_end) { tr_describe(P, job, J[q]);
        const float* src = (c8 < 32 ? J[q].sa + c8 : J[q].sb + (c8 - 32)) + (size_t)k * J[q].lds;
        a[q] = __builtin_nontemporal_load((const f32x4*)src); b[q] = __builtin_nontemporal_load((const f32x4*)(src + 4));
        sc[q] = J[q].scale ? J[q].scale[k] : 1.0f; } }
    asm volatile("s_waitcnt vmcnt(0)" ::: "memory");
#pragma unroll
    for (int q = 0; q < 4; ++q) if (job0 + q * jstep < njobs_end) { LAS float* t = tl + q * (64 * 65) + k * 65 + c8;
        t[0] = a[q][0] * sc[q]; t[1] = a[q][1] * sc[q]; t[2] = a[q][2] * sc[q]; t[3] = a[q][3] * sc[q]; t[4] = b[q][0] * sc[q]; t[5] = b[q][1] * sc[q]; t[6] = b[q][2] * sc[q]; t[7] = b[q][3] * sc[q]; }
    __syncthreads();
    const int n = tid >> 3, k8 = (tid & 7) * 8;
#pragma unroll
    for (int q = 0; q < 4; ++q) if (job0 + q * jstep < njobs_end) { const LAS float* t = tl + q * (64 * 65);
        u32x4 w;
        w.x = cvt_pk_bf16(t[(k8 + 0) * 65 + n], t[(k8 + 1) * 65 + n]); w.y = cvt_pk_bf16(t[(k8 + 2) * 65 + n], t[(k8 + 3) * 65 + n]);
        w.z = cvt_pk_bf16(t[(k8 + 4) * 65 + n], t[(k8 + 5) * 65 + n]); w.w = cvt_pk_bf16(t[(k8 + 6) * 65 + n], t[(k8 + 7) * 65 + n]);
        *(u32x4*)(J[q].dst + (size_t)n * J[q].ldd + k8) = w; }
    __syncthreads();
}

#define N_TR_JOBS 3648
__device__ __forceinline__ void phase0_weights(const Params& P, int bid, int nblk, int tid, LAS float* tl) {
    for (int job = bid; job < 3520; job += 4 * nblk) tr_round(P, job, nblk, 3520, tl, tid);
    for (int job = 3520 + bid; job < N_TR_JOBS; job += nblk) {
        {
            const int j = job - 3520, n0 = (j >> 4) * 64, k0 = (j & 15) * 64, g = n0 >> 7, d0 = n0 & 127;
            LAS float* wa = tl + 64 * 65;
            LAS float* pb = wa + 64 * 129;
            for (int i = tid; i < 64 * 32; i += NTHR) { const int k = i >> 5, c4 = (i & 31) * 4; const f32x4 v = *(const f32x4*)(P.w_in + (size_t)(k0 + k) * DM + 128 * g + c4);
                LAS float* t = wa + k * 129 + c4; t[0] = v[0]; t[1] = v[1]; t[2] = v[2]; t[3] = v[3]; }
            for (int i = tid; i < 128 * 16; i += NTHR) { const int cc = i >> 4, d4 = (i & 15) * 4; const f32x4 v = *(const f32x4*)(P.pool_w + ((size_t)g * 128 + cc) * 128 + d0 + d4);
                LAS float* t = pb + cc * 65 + d4; t[0] = v[0]; t[1] = v[1]; t[2] = v[2]; t[3] = v[3]; }
            __syncthreads();
            {
                const int k = tid >> 3, dl = tid & 7; float a[8];
#pragma unroll
                for (int q = 0; q < 8; ++q) a[q] = 0.f;
                for (int cc = 0; cc < 128; ++cc) { const float wv = wa[k * 129 + cc];
#pragma unroll
                    for (int q = 0; q < 8; ++q) a[q] += wv * pb[cc * 65 + dl + 8 * q]; }
                const float nm = P.norm_mix[k0 + k];
#pragma unroll
                for (int q = 0; q < 8; ++q) tl[k * 65 + dl + 8 * q] = a[q] * nm * P.pool_scale[n0 + dl + 8 * q];
            }
            __syncthreads();
            { const int n = tid >> 3, k8 = (tid & 7) * 8; u32x4 w;
              w.x = cvt_pk_bf16(tl[(k8 + 0) * 65 + n], tl[(k8 + 1) * 65 + n]); w.y = cvt_pk_bf16(tl[(k8 + 2) * 65 + n], tl[(k8 + 3) * 65 + n]);
              w.z = cvt_pk_bf16(tl[(k8 + 4) * 65 + n], tl[(k8 + 5) * 65 + n]); w.w = cvt_pk_bf16(tl[(k8 + 6) * 65 + n], tl[(k8 + 7) * 65 + n]);
              *(u32x4*)(P.w_inT() + (size_t)(n0 + n) * DM + k0 + k8) = w; }
            __syncthreads();
        }
    }
    for (int i = bid * NTHR + tid; i < 32 * DM; i += nblk * NTHR) {
        const int j = i >> 10, k = i & 1023; float v = 0.f;
        if (j < 4) v = P.norm_ffn[k] * P.rc_w[k * 4 + j]; else if (j < 20) v = P.norm_ffn[k] * P.rf_w[k * 16 + j - 4];
        P.wrT()[i] = f2bf(v);
    }
}

__device__ __forceinline__ void phaseA(const Params& P, LAS unsigned char* lds, int bid, int nblk, int tid) {
    const int wid = __builtin_amdgcn_readfirstlane(tid >> 6), lane = tid & 63, wr = wid >> 2, wc = wid & 3, fr = lane & 15, fq = lane >> 4;
    for (int u = bid; u < 1024; u += nblk) {
        const int i = u / nblk, b = u % nblk;
        int mt, nt;
        if (nblk == 256) { const int xcd = b & 7, idx = b >> 3; mt = (i * 8 + xcd) * 8 + (idx >> 2); nt = idx & 3; } else { mt = u >> 2; nt = u & 3; }
        StagePtrs sp; sp.a[2] = nullptr; sp.ksplit = 1 << 30; sp.bdelta = 0; sp.kt0 = 0; sp.nkt = 1 << 30;
#pragma unroll
        for (int j = 0; j < 2; ++j) { const int r = stage_row_a(wid, lane, j); sp.a[j] = (const char*)(P.xb() + (size_t)(mt * 128 + r) * DM) + stage_chunk_off(r, lane); }
#pragma unroll
        for (int j = 0; j < 4; ++j) { const int r = stage_row_b(wid, lane, j); sp.b[j] = (const char*)(P.w_inT() + (size_t)(nt * 256 + r) * DM) + stage_chunk_off(r, lane); }
        f32x4 acc[4][4]; acc_zero<4>(acc);
        gemm_core<4>(lds, sp, DM / 64, acc, wid, wr, wc, lane, false);
        float rsm[4];
#pragma unroll
        for (int m = 0; m < 4; ++m) rsm[m] = P.rstd1()[mt * 128 + wr * 64 + m * 16 + fr];
        asm volatile("s_waitcnt vmcnt(0)" ::: "memory");
#pragma unroll
        for (int m = 0; m < 4; ++m) {
            const int row = mt * 128 + wr * 64 + m * 16 + fr; const float rs = rsm[m];
            bf16_t* zr = P.z() + (size_t)row * DM + nt * 256 + wc * 64 + 4 * fq;
#pragma unroll
            for (int n = 0; n < 4; ++n) { u32x2 w; w.x = cvt_pk_bf16(acc[m][n][0] * rs, acc[m][n][1] * rs); w.y = cvt_pk_bf16(acc[m][n][2] * rs, acc[m][n][3] * rs); *(u32x2*)(zr + n * 16) = w; }
        }
    }
}


__device__ __forceinline__ void phase0_ssm(const Params& P, int bid, int nblk, int tid) {
    for (int i = bid * NTHR + tid; i < 2048; i += nblk * NTHR) {
        const int g = i >> 6;
        const double lr = (double)P.a_re[i], li = (double)P.a_im[i], step = exp((double)P.log_step[g]);
        const double mag = exp(lr * step), ar = mag * cos(li * step), ai = mag * sin(li * step);
        const double den = lr * lr + li * li, nr = ar - 1.0, ni = ai;
        const double qr = (nr * lr + ni * li) / den, qi = (ni * lr - nr * li) / den;
        P.abar()[2 * i] = (float)ar; P.abar()[2 * i + 1] = (float)ai;
        const double m64 = exp(64.0 * lr * step), m128 = exp(128.0 * lr * step);
        P.a64()[2 * i] = (float)(m64 * cos(64.0 * li * step)); P.a64()[2 * i + 1] = (float)(m64 * sin(64.0 * li * step));
        P.a128()[2 * i] = (float)(m128 * cos(128.0 * li * step)); P.a128()[2 * i + 1] = (float)(m128 * sin(128.0 * li * step));
        const int p = i & 63;
        float brv[16], biv[16];
#pragma unroll
        for (int h = 0; h < 16; ++h) { brv[h] = P.b_re[i * 16 + h]; biv[h] = P.b_im[i * 16 + h]; }
        asm volatile("s_waitcnt vmcnt(0)" ::: "memory");
#pragma unroll
        for (int h = 0; h < 16; ++h) {
            const double br = (double)brv[h], bi = (double)biv[h];
            P.bbT()[((size_t)g * 128 + p) * 16 + h] = f2bf((float)(qr * br - qi * bi));
            P.bbT()[((size_t)g * 128 + 64 + p) * 16 + h] = f2bf((float)(qr * bi + qi * br));
        }
    }
    for (int i = bid * NTHR + tid; i < 32 * 16 * 160; i += nblk * NTHR) {
        const int k = i % 160, gh = i / 160, h = gh & 15;
        float v = 0.f;
        if (k < 128) v = (k & 1) ? -P.c_im[gh * 64 + (k >> 1)] : P.c_re[gh * 64 + (k >> 1)];
        else if (k - 128 == h) v = P.ssm_d[gh];
        P.cmT()[i] = f2bf(v);
    }
}

struct SsmGroup { bf16x8 bop[4]; float ar[2], ai[2]; };
__device__ __forceinline__ void ssm_load_group(const Params& P, int g, int lane, SsmGroup& G) {
#pragma unroll
    for (int cb = 0; cb < 4; ++cb) G.bop[cb] = *(const bf16x8*)(P.bbT() + ((size_t)g * 128 + 32 * cb + (lane & 31)) * 16 + 8 * (lane >> 5));
#pragma unroll
    for (int sp = 0; sp < 2; ++sp) { const int s = g * 64 + 32 * sp + (lane & 31); G.ar[sp] = P.abar()[2 * s]; G.ai[sp] = P.abar()[2 * s + 1]; }
}
__device__ __forceinline__ int ssm_row_token(int lane, int j) { const int r = lane & 31; return 64 * ((r >> 2) & 1) + 16 * j + (r & 3) + 4 * (r >> 3); }

__device__ __forceinline__ void phaseA2(const Params& P, int bid, int nblk, int tid) {
    const int wid = tid >> 6, lane = tid & 63;
    for (int c = bid; c < 256; c += nblk) {
        for (int gi = 0; gi < 4; ++gi) {
            const int g = wid * 4 + gi;
            SsmGroup G; ssm_load_group(P, g, lane, G);
            float xr[2] = {0.f, 0.f}, xi[2] = {0.f, 0.f};
#pragma unroll 1
            for (int j = 0; j < 4; ++j) {
                const int tok = c * 128 + ssm_row_token(lane, j);
                const bf16x8 aop = *(const bf16x8*)(P.z() + (size_t)tok * DM + 512 + 16 * g + 8 * (lane >> 5));
                f32x16 bu[4];
#pragma unroll
                for (int cb = 0; cb < 4; ++cb) { f32x16 zz; for (int q = 0; q < 16; ++q) zz[q] = 0.f; bu[cb] = __builtin_amdgcn_mfma_f32_32x32x16_bf16(aop, G.bop[cb], zz, 0, 0, 0); }
#pragma unroll
                for (int i = 0; i < 16; ++i)
#pragma unroll
                    for (int sp = 0; sp < 2; ++sp) {
                        const float nxr = G.ar[sp] * xr[sp] - G.ai[sp] * xi[sp] + bu[sp][i];
                        const float nxi = G.ar[sp] * xi[sp] + G.ai[sp] * xr[sp] + bu[2 + sp][i];
                        xr[sp] = nxr; xi[sp] = nxi;
                    }
            }
#pragma unroll
            for (int sp = 0; sp < 2; ++sp) {
                const float s1r = __shfl(xr[sp], (lane & 31) + 32), s1i = __shfl(xi[sp], (lane & 31) + 32);
                if (lane < 32) {
                    const int s = g * 64 + 32 * sp + lane;
                    const float pr = P.a64()[2 * s], pi = P.a64()[2 * s + 1];
                    asm volatile("s_waitcnt vmcnt(0)" ::: "memory");
                    const size_t o = ((size_t)c * 2048 + s) * 2;
                    P.send0()[o] = xr[sp]; P.send0()[o + 1] = xi[sp];
                    P.send128()[o] = pr * xr[sp] - pi * xi[sp] + s1r; P.send128()[o + 1] = pr * xi[sp] + pi * xr[sp] + s1i;
                }
            }
        }
    }
}

#define XA_STRIDE 336
__device__ __forceinline__ float gelu_tanh(float y) { const float a = 1.5957691216057308f * (y + 0.044715f * y * y * y); return y / (1.0f + __expf(-a)); }

__device__ __forceinline__ void phaseB_ssm(const Params& P, LAS unsigned char* lds, int c, int tid) {
    const int wid = tid >> 6, lane = tid & 63;
    LAS float* carry = (LAS float*)(lds + 86016);
    {
        const int c0 = c & ~63;
        f32x4 cr0 = {0.f, 0.f, 0.f, 0.f}, cr1 = {0.f, 0.f, 0.f, 0.f};
        const f32x4 p0 = *(const f32x4*)(P.a128() + 8 * tid), p1 = *(const f32x4*)(P.a128() + 8 * tid + 4);
        int cc = c0;
        for (; cc + 8 <= c; cc += 8) {
            f32x4 s0[8], s1[8];
#pragma unroll
            for (int q = 0; q < 8; ++q) { s0[q] = *(const f32x4*)(P.send128() + (size_t)(cc + q) * 4096 + 8 * tid); s1[q] = *(const f32x4*)(P.send128() + (size_t)(cc + q) * 4096 + 8 * tid + 4); }
#pragma unroll
            for (int q = 0; q < 8; ++q) {
                f32x4 n0, n1;
                n0[0] = p0[0] * cr0[0] - p0[1] * cr0[1] + s0[q][0]; n0[1] = p0[0] * cr0[1] + p0[1] * cr0[0] + s0[q][1];
                n0[2] = p0[2] * cr0[2] - p0[3] * cr0[3] + s0[q][2]; n0[3] = p0[2] * cr0[3] + p0[3] * cr0[2] + s0[q][3];
                n1[0] = p1[0] * cr1[0] - p1[1] * cr1[1] + s1[q][0]; n1[1] = p1[0] * cr1[1] + p1[1] * cr1[0] + s1[q][1];
                n1[2] = p1[2] * cr1[2] - p1[3] * cr1[3] + s1[q][2]; n1[3] = p1[2] * cr1[3] + p1[3] * cr1[2] + s1[q][3];
                cr0 = n0; cr1 = n1;
            }
        }
        for (; cc < c; ++cc) {
            const f32x4 s0 = *(const f32x4*)(P.send128() + (size_t)cc * 4096 + 8 * tid), s1 = *(const f32x4*)(P.send128() + (size_t)cc * 4096 + 8 * tid + 4);
            f32x4 n0, n1;
            n0[0] = p0[0] * cr0[0] - p0[1] * cr0[1] + s0[0]; n0[1] = p0[0] * cr0[1] + p0[1] * cr0[0] + s0[1];
            n0[2] = p0[2] * cr0[2] - p0[3] * cr0[3] + s0[2]; n0[3] = p0[2] * cr0[3] + p0[3] * cr0[2] + s0[3];
            n1[0] = p1[0] * cr1[0] - p1[1] * cr1[1] + s1[0]; n1[1] = p1[0] * cr1[1] + p1[1] * cr1[0] + s1[1];
            n1[2] = p1[2] * cr1[2] - p1[3] * cr1[3] + s1[2]; n1[3] = p1[2] * cr1[3] + p1[3] * cr1[2] + s1[3];
            cr0 = n0; cr1 = n1;
        }
        *(LAS f32x4*)(carry + 8 * tid) = cr0; *(LAS f32x4*)(carry + 8 * tid + 4) = cr1;
    }
    LAS unsigned char* XA = lds + wid * (32 * XA_STRIDE);
    if (lane < 32) { const u32x4 zz = {0u, 0u, 0u, 0u}; *(LAS u32x4*)(XA + lane * XA_STRIDE + 288) = zz; *(LAS u32x4*)(XA + lane * XA_STRIDE + 304) = zz; }
    __syncthreads();
    for (int gi = 0; gi < 4; ++gi) {
        const int g = wid * 4 + gi;
        SsmGroup G; ssm_load_group(P, g, lane, G);
        bf16x8 cf[5];
#pragma unroll
        for (int ks = 0; ks < 5; ++ks) cf[ks] = *(const bf16x8*)(P.cmT() + ((size_t)g * 16 + (lane & 15)) * 160 + 32 * ks + 8 * (lane >> 4));
        float xr[2], xi[2];
#pragma unroll
        for (int sp = 0; sp < 2; ++sp) {
            const int s = g * 64 + 32 * sp + (lane & 31);
            const float c0r = carry[2 * s], c0i = carry[2 * s + 1];
            if (lane < 32) { xr[sp] = c0r; xi[sp] = c0i; }
            else { const float pr = P.a64()[2 * s], pi = P.a64()[2 * s + 1]; const size_t o = ((size_t)c * 2048 + s) * 2;
                   xr[sp] = pr * c0r - pi * c0i + P.send0()[o]; xi[sp] = pr * c0i + pi * c0r + P.send0()[o + 1]; }
        }
        bf16x8 aops[4];
#pragma unroll
        for (int j = 0; j < 4; ++j) aops[j] = *(const bf16x8*)(P.z() + (size_t)(c * 128 + ssm_row_token(lane, j)) * DM + 512 + 16 * g + 8 * (lane >> 5));
        asm volatile("s_waitcnt vmcnt(0)" ::: "memory");
#pragma unroll
        for (int j = 0; j < 4; ++j) {
            const bf16x8 aop = aops[j];
            f32x16 bu[4];
#pragma unroll
            for (int cb = 0; cb < 4; ++cb) { f32x16 zz; for (int q = 0; q < 16; ++q) zz[q] = 0.f; bu[cb] = __builtin_amdgcn_mfma_f32_32x32x16_bf16(aop, G.bop[cb], zz, 0, 0, 0); }
            { const int r = lane & 31, xrow = 16 * ((r >> 2) & 1) + (r & 3) + 4 * (r >> 3); *(LAS bf16x8*)(XA + xrow * XA_STRIDE + 256 + 16 * (lane >> 5)) = aop; }
            LAS unsigned char* xw = XA + (16 * (lane >> 5)) * XA_STRIDE + 4 * (lane & 31);
#pragma unroll
            for (int i = 0; i < 16; ++i) {
#pragma unroll
                for (int sp = 0; sp < 2; ++sp) {
                    const float nxr = G.ar[sp] * xr[sp] - G.ai[sp] * xi[sp] + bu[sp][i];
                    const float nxi = G.ar[sp] * xi[sp] + G.ai[sp] * xr[sp] + bu[2 + sp][i];
                    xr[sp] = nxr; xi[sp] = nxi;
                    *(LAS unsigned*)(xw + i * XA_STRIDE + 128 * sp) = cvt_pk_bf16(nxr, nxi);
                }
            }
            asm volatile("s_waitcnt lgkmcnt(0)" ::: "memory");
#pragma unroll
            for (int rg = 0; rg < 2; ++rg) {
                f32x4 ay = {0.f, 0.f, 0.f, 0.f};
#pragma unroll
                for (int ks = 0; ks < 5; ++ks) {
                    const bf16x8 xf = *(const LAS bf16x8*)(XA + (16 * rg + (lane & 15)) * XA_STRIDE + 64 * ks + 16 * (lane >> 4));
                    ay = __builtin_amdgcn_mfma_f32_16x16x32_bf16(cf[ks], xf, ay, 0, 0, 0);
                }
                const int tok = c * 128 + 64 * rg + 16 * j + (lane & 15);
                u32x2 w; w.x = cvt_pk_bf16(gelu_tanh(ay[0]), gelu_tanh(ay[1])); w.y = cvt_pk_bf16(gelu_tanh(ay[2]), gelu_tanh(ay[3]));
                *(u32x2*)(P.ybuf() + (size_t)tok * 512 + 16 * g + 4 * (lane >> 4)) = w;
            }
            asm volatile("s_waitcnt lgkmcnt(0)" ::: "memory");
        }
    }
}


template <int W>
__device__ __forceinline__ void pool_channel(const Params& P, int c, int ch) {
    const int t0 = c * 128, pos0 = t0 & (SEQ - 1);
    const bf16_t* zc = P.z() + ch;
    float prev[16], cur[16];
#pragma unroll
    for (int i = 0; i < 16; ++i) prev[i] = (pos0 > 0) ? bf2f(zc[(size_t)(t0 - 16 + i) * DM]) : 0.f;
#pragma unroll 1
    for (int b = 0; b < 8; ++b) {
        const int tb = t0 + 16 * b, posb = pos0 + 16 * b;
#pragma unroll
        for (int i = 0; i < 16; ++i) cur[i] = bf2f(zc[(size_t)(tb + i) * DM]);
        asm volatile("s_waitcnt vmcnt(0)" ::: "memory");
#pragma unroll
        for (int i = 0; i < 16; ++i) {
            float a = 0.f;
#pragma unroll
            for (int j = 0; j < W; ++j) a += (i - j >= 0) ? cur[(i - j >= 0) ? i - j : 0] : prev[(i - j < 0) ? 16 + i - j : 0];
            const int pos = posb + i;
            const float inv = (pos + 1 < W) ? 1.0f / (float)(pos + 1) : (1.0f / (float)W);
            P.ycat()[(size_t)(tb + i) * DM + ch] = f2bf(a * inv - cur[i]);
        }
#pragma unroll
        for (int i = 0; i < 16; ++i) prev[i] = cur[i];
    }
}
__device__ __forceinline__ void phaseB_pool(const Params& P, int c, int tid) {
    const int gi = __builtin_amdgcn_readfirstlane(tid >> 7);
    if (gi == 0) pool_channel<2>(P, c, tid); else if (gi == 1) pool_channel<4>(P, c, tid); else if (gi == 2) pool_channel<8>(P, c, tid); else pool_channel<16>(P, c, tid);
}

__device__ __forceinline__ void phaseB_glu(const Params& P, LAS unsigned char* lds, int c, int tid) {
    const int wid = __builtin_amdgcn_readfirstlane(tid >> 6), lane = tid & 63, wr = wid >> 2, wc = wid & 3, fr = lane & 15, fq = lane >> 4;
#pragma unroll 1
    for (int nt_ = 0; nt_ < 2; ++nt_) {
        const int nt = (nt_ + c) & 1;
        StagePtrs sp; sp.a[2] = nullptr; sp.ksplit = 1 << 30; sp.bdelta = 0; sp.kt0 = (c >> 1) & 7; sp.nkt = 8;
#pragma unroll
        for (int j = 0; j < 2; ++j) { const int r = stage_row_a(wid, lane, j); sp.a[j] = (const char*)(P.ybuf() + (size_t)(c * 128 + r) * 512) + stage_chunk_off(r, lane); }
#pragma unroll
        for (int j = 0; j < 4; ++j) { const int r = stage_row_b(wid, lane, j); sp.b[j] = (const char*)(P.gluT() + (size_t)(nt * 256 + r) * 512) + stage_chunk_off(r, lane); }
        f32x4 acc[4][4]; acc_zero<4>(acc);
        gemm_core<4>(lds, sp, 512 / 64, acc, wid, wr, wc, lane, nt_ == 0);
#pragma unroll
        for (int m = 0; m < 4; ++m) {
            const int row = c * 128 + wr * 64 + m * 16 + fr;
            f32x4 bb[4]; u32x2 yw[4];
#pragma unroll
            for (int n = 0; n < 4; ++n) { const int col = nt * 256 + wc * 64 + n * 16 + 4 * fq; bb[n] = *(const f32x4*)(P.glu_b + col); yw[n] = *(const u32x2*)(P.ybuf() + (size_t)row * 512 + col); }
            asm volatile("s_waitcnt vmcnt(0)" ::: "memory");
#pragma unroll
            for (int n = 0; n < 4; ++n) {
                const int col = nt * 256 + wc * 64 + n * 16 + 4 * fq;
                const float y0 = bflo(yw[n].x), y1 = bfhi(yw[n].x), y2 = bflo(yw[n].y), y3 = bfhi(yw[n].y);
                u32x2 w;
                w.x = cvt_pk_bf16(y0 / (1.0f + __expf(-(acc[m][n][0] + bb[n][0]))), y1 / (1.0f + __expf(-(acc[m][n][1] + bb[n][1]))));
                w.y = cvt_pk_bf16(y2 / (1.0f + __expf(-(acc[m][n][2] + bb[n][2]))), y3 / (1.0f + __expf(-(acc[m][n][3] + bb[n][3]))));
                *(u32x2*)(P.ycat() + (size_t)row * DM + 512 + col) = w;
            }
        }
    }
}

__device__ __forceinline__ void phaseB_wout(const Params& P, LAS unsigned char* lds, int c, int tid) {
    const int wid = __builtin_amdgcn_readfirstlane(tid >> 6), lane = tid & 63, wr = wid >> 2, wc = wid & 3, fr = lane & 15, fq = lane >> 4;
    LAS float* rowss = (LAS float*)(lds + MISC_OFF);
    LAS float* sspart = (LAS float*)(lds + MISC_OFF + 1024);
#pragma unroll 1
    for (int nt_ = 0; nt_ < 4; ++nt_) {
        const int nt = nt_;
        StagePtrs sp; sp.a[2] = nullptr; sp.ksplit = 1 << 30; sp.bdelta = 0; sp.kt0 = (c >> 2) & 15; sp.nkt = 16;
#pragma unroll
        for (int j = 0; j < 2; ++j) { const int r = stage_row_a(wid, lane, j); sp.a[j] = (const char*)(P.ycat() + (size_t)(c * 128 + r) * DM) + stage_chunk_off(r, lane); }
#pragma unroll
        for (int j = 0; j < 4; ++j) { const int r = stage_row_b(wid, lane, j); sp.b[j] = (const char*)(P.w_outT() + (size_t)(nt * 256 + r) * DM) + stage_chunk_off(r, lane); }
        f32x4 acc[4][4]; acc_zero<4>(acc);
        gemm_core<4>(lds, sp, DM / 64, acc, wid, wr, wc, lane, nt_ == 0);
#pragma unroll
        for (int m = 0; m < 4; ++m) {
            const int lrow = wr * 64 + m * 16 + fr; const size_t row = (size_t)c * 128 + lrow;
            float ss = 0.f;
            u32x2 xw[4];
#pragma unroll
            for (int n = 0; n < 4; ++n) xw[n] = *(const u32x2*)(P.xb() + row * DM + nt * 256 + wc * 64 + n * 16 + 4 * fq);
            asm volatile("s_waitcnt vmcnt(0)" ::: "memory");
#pragma unroll
            for (int n = 0; n < 4; ++n) {
                const int col = nt * 256 + wc * 64 + n * 16 + 4 * fq;
                f32x4 v = acc[m][n]; v[0] += bflo(xw[n].x); v[1] += bfhi(xw[n].x); v[2] += bflo(xw[n].y); v[3] += bfhi(xw[n].y);
                u32x2 w; w.x = cvt_pk_bf16(v[0], v[1]); w.y = cvt_pk_bf16(v[2], v[3]);
                *(u32x2*)(P.x1b() + row * DM + col) = w;
                ss += v[0] * v[0] + v[1] * v[1] + v[2] * v[2] + v[3] * v[3];
            }
            ss += __shfl_xor(ss, 16); ss += __shfl_xor(ss, 32);
            if (fq == 0) sspart[lrow * 16 + nt * 4 + wc] = ss;
        }
    }
    asm volatile("s_waitcnt vmcnt(0)" ::: "memory");
    __syncthreads();
    if (tid < 128) { float t = 0.f;
#pragma unroll
        for (int q = 0; q < 16; ++q) t += sspart[tid * 16 + q];
        const float r = rsqrtf(t * (1.0f / DM) + EPSV); P.rstd2()[c * 128 + tid] = r; rowss[tid] = r; }
    __syncthreads();
}


#define LG_OFF (MISC_OFF + 1024)
#define CNT_OFF (MISC_OFF + 1024 + 10240)
__device__ __forceinline__ void phaseB_router(const Params& P, LAS unsigned char* lds, int c, int tid) {
    const int wid = tid >> 6, lane = tid & 63, l15 = lane & 15, fq = lane >> 4;
    LAS float* rowss = (LAS float*)(lds + MISC_OFF);
    LAS float* lg = (LAS float*)(lds + LG_OFF);
    LAS int* lcnt = (LAS int*)(lds + CNT_OFF);
    if (tid < 48) lcnt[tid] = 0;
    {
        f32x4 a0 = {0.f, 0.f, 0.f, 0.f}, a1 = {0.f, 0.f, 0.f, 0.f};
        const bf16_t* xr = P.x1b() + (size_t)(c * 128 + wid * 16 + l15) * DM + 8 * fq;
        const bf16_t* w0 = P.wrT() + (size_t)l15 * DM + 8 * fq;
        const bf16_t* w1 = P.wrT() + (size_t)(16 + l15) * DM + 8 * fq;
#pragma unroll 8
        for (int ks = 0; ks < 32; ++ks) {
            const bf16x8 xf = *(const bf16x8*)(xr + 32 * ks), f0 = *(const bf16x8*)(w0 + 32 * ks), f1 = *(const bf16x8*)(w1 + 32 * ks);
            a0 = __builtin_amdgcn_mfma_f32_16x16x32_bf16(f0, xf, a0, 0, 0, 0);
            a1 = __builtin_amdgcn_mfma_f32_16x16x32_bf16(f1, xf, a1, 0, 0, 0);
        }
        const int r = wid * 16 + l15;
#pragma unroll
        for (int q = 0; q < 4; ++q) lg[r * 20 + 4 * fq + q] = a0[q];
        if (fq == 0) {
#pragma unroll
            for (int q = 0; q < 4; ++q) lg[r * 20 + 16 + q] = a1[q];
        }
    }
    __syncthreads();
    int cls = 0, rank = 0; float wlo = 0.f, whi = 0.f;
    if (tid < 128) {
        const float rs = rowss[tid];
        float cl[4];
#pragma unroll
        for (int j = 0; j < 4; ++j) cl[j] = lg[tid * 20 + j] * rs + P.rc_b[j];
        int gi = 0; float mx = cl[0];
#pragma unroll
        for (int j = 1; j < 4; ++j) if (cl[j] > mx) { mx = cl[j]; gi = j; }
        float se = 0.f;
#pragma unroll
        for (int j = 0; j < 4; ++j) se += __expf(cl[j] - mx);
        const float pg = 1.0f / se;
        float f[4];
#pragma unroll
        for (int j = 0; j < 4; ++j) {
            float v = lg[tid * 20 + 4 + j] ;
            v = (gi == 1) ? lg[tid * 20 + 8 + j] : v; v = (gi == 2) ? lg[tid * 20 + 12 + j] : v; v = (gi == 3) ? lg[tid * 20 + 16 + j] : v;
            f[j] = v * rs + P.rf_b[gi * 4 + j];
        }
        int i0 = 0; float v0 = f[0];
#pragma unroll
        for (int j = 1; j < 4; ++j) if (f[j] > v0) { v0 = f[j]; i0 = j; }
        int i1 = -1; float v1 = 0.f;
#pragma unroll
        for (int j = 0; j < 4; ++j) if (j != i0 && (i1 < 0 || f[j] > v1)) { v1 = f[j]; i1 = j; }
        const float e1 = __expf(v1 - v0);
        const float wa = pg / (1.0f + e1), wb = pg * e1 / (1.0f + e1);
        const int lo = i0 < i1 ? i0 : i1, hi = i0 < i1 ? i1 : i0;
        wlo = (i0 < i1) ? wa : wb; whi = (i0 < i1) ? wb : wa;
        const int pidx = (lo == 0) ? (hi - 1) : ((lo == 1) ? (hi + 1) : 5);
        cls = gi * 6 + pidx;
        rank = __hip_atomic_fetch_add(&lcnt[cls], 1, __ATOMIC_RELAXED, __HIP_MEMORY_SCOPE_WORKGROUP);
    }
    __syncthreads();
    if (tid < 24) { const int n = lcnt[tid]; lcnt[24 + tid] = n ? (int)atomicAdd((unsigned*)P.ctl() + 64 + tid, (unsigned)n) : 0; }
    __syncthreads();
    if (tid < 128) {
        const int tok = c * 128 + tid;
        P.perm()[(size_t)cls * T_TOK + lcnt[24 + cls] + rank] = tok;
        P.tokw()[2 * tok] = wlo; P.tokw()[2 * tok + 1] = whi;
    }
}

#define C_ROWS 144
#define C_STAGE (C_ROWS * 128 + 32768)
#define C_MISC (3 * C_STAGE)
#define C_TOK_OFF (C_MISC)
#define C_RS_OFF (C_MISC + 576)
#define C_WL_OFF (C_MISC + 1152)
#define C_WH_OFF (C_MISC + 1728)
#define C_SS_OFF (C_MISC + 2304)
__device__ __forceinline__ void phaseC(const Params& P, LAS unsigned char* lds, int bid, int nblk, int tid_) {
    int tid = tid_;
    const int wid = __builtin_amdgcn_readfirstlane(tid >> 6), wr = wid >> 2, wc = wid & 3;
    const int rowbase = wr ? 80 : 0;
    LAS int* rowtok = (LAS int*)(lds + C_TOK_OFF);
    LAS float* rsv = (LAS float*)(lds + C_RS_OFF);
    LAS float* wlv = (LAS float*)(lds + C_WL_OFF);
    LAS float* whv = (LAS float*)(lds + C_WH_OFF);
    LAS float* sspart = (LAS float*)(lds + C_SS_OFF);
    const unsigned* gcnt = P.ctl() + 64;
    int total = 0;
    for (int k = 0; k < 24; ++k) total += ((int)gcnt[k] + C_ROWS - 1) / C_ROWS;
    for (int u = bid; u < total; u += nblk) {
        int cls = 0, j = u, cnt = 0;
        for (int k = 0; k < 24; ++k) { const int n = (int)gcnt[k], t = (n + C_ROWS - 1) / C_ROWS; if (j < t) { cls = k; cnt = n; break; } j -= t; }
        const int ntile = (cnt + C_ROWS - 1) / C_ROWS, rbeg = (int)(((long)cnt * j) / ntile), rend = (int)(((long)cnt * (j + 1)) / ntile), nvalid = rend - rbeg;
        __syncthreads();
        if (tid < C_ROWS) {
            const int r = tid < nvalid ? tid : nvalid - 1;
            const int tok = P.perm()[(size_t)cls * T_TOK + rbeg + r];
            rowtok[tid] = tok; rsv[tid] = P.rstd2()[tok]; wlv[tid] = P.tokw()[2 * tok]; whv[tid] = P.tokw()[2 * tok + 1];
        }
        __syncthreads();
        const int gi = cls / 6, pidx = cls - gi * 6;
        const int lo = pidx < 3 ? 0 : (pidx < 5 ? 1 : 2), hi = pidx < 3 ? pidx + 1 : (pidx < 5 ? pidx - 1 : 3);
        const int e_lo = gi * 4 + lo, e_hi = gi * 4 + hi;
        bf16_t* hid = P.hid() + (size_t)u * C_ROWS * 512;
        bf16_t* x2s = P.z() + (size_t)u * C_ROWS * DM;
        { asm volatile("" : "+v"(tid)); const int lane = tid & 63, fr = lane & 15, fq = lane >> 4;
#pragma unroll 1
        for (int s = 0; s < 2; ++s) {
            const int e = s ? e_hi : e_lo;
#pragma unroll 1
            for (int ch = 0; ch < 2; ++ch) {
                StagePtrs sp; sp.ksplit = 1 << 30; sp.bdelta = 0; sp.kt0 = 0; sp.nkt = 1 << 30;
#pragma unroll
                for (int q = 0; q < 3; ++q) { const int r = stage_row_a(wid, lane, q) < C_ROWS ? stage_row_a(wid, lane, q) : 0; sp.a[q] = (const char*)(P.x1b() + (size_t)rowtok[r] * DM) + stage_chunk_off(r, lane); }
#pragma unroll
                for (int q = 0; q < 4; ++q) { const int r = stage_row_b(wid, lane, q); sp.b[q] = (const char*)(P.wguT() + ((size_t)(e * 2 + ch) * 256 + r) * DM) + stage_chunk_off(r, lane); }
                f32x4 acc[5][4]; acc_zero<5>(acc);
                gemm_core<5>(lds, sp, DM / 64, acc, wid, wr, wc, lane, s == 0 && ch == 0);
#pragma unroll
                for (int m = 0; m < 5; ++m) if (m < 4 || wr == 0) {
                    const int r = rowbase + m * 16 + fr; const float rs = rsv[r], wsel = s ? whv[r] : wlv[r];
#pragma unroll
                    for (int n = 0; n < 2; ++n) {
                        float h[4];
#pragma unroll
                        for (int q = 0; q < 4; ++q) { const float g = acc[m][n][q] * rs, uu = acc[m][n + 2][q] * rs; h[q] = g / (1.0f + __expf(-g)) * uu * wsel; }
                        u32x2 w; w.x = cvt_pk_bf16(h[0], h[1]); w.y = cvt_pk_bf16(h[2], h[3]);
                        *(u32x2*)(hid + (size_t)r * 512 + 256 * s + 128 * ch + 32 * wc + 16 * n + 4 * fq) = w;
                    }
                    asm volatile("" ::: "memory");
                }
            }
        }
        }
        { asm volatile("" : "+v"(tid)); const int lane = tid & 63, fr = lane & 15, fq = lane >> 4;
        float ssr[5] = {0.f, 0.f, 0.f, 0.f, 0.f};
#pragma unroll 1
        for (int nt = 0; nt < 4; ++nt) {
            StagePtrs sp; sp.ksplit = 4; sp.bdelta = (long)(e_hi - e_lo) * DM * 256 * 2; sp.kt0 = 0; sp.nkt = 1 << 30;
#pragma unroll
            for (int q = 0; q < 3; ++q) { const int r = stage_row_a(wid, lane, q) < C_ROWS ? stage_row_a(wid, lane, q) : 0; sp.a[q] = (const char*)(hid + (size_t)r * 512) + stage_chunk_off(r, lane); }
#pragma unroll
            for (int q = 0; q < 4; ++q) { const int r = stage_row_b(wid, lane, q); sp.b[q] = (const char*)(P.wdT() + ((size_t)e_lo * DM + nt * 256 + r) * 256) + stage_chunk_off(r, lane); }
            f32x4 acc[5][4]; acc_zero<5>(acc);
            gemm_core<5>(lds, sp, 8, acc, wid, wr, wc, lane, nt == 0);
#pragma unroll
            for (int m = 0; m < 5; ++m) if (m < 4 || wr == 0) {
                const int r = rowbase + m * 16 + fr;
                if (r < nvalid) {
                    const bf16_t* xrow = P.x1b() + (size_t)rowtok[r] * DM + nt * 256 + wc * 64 + 4 * fq; bf16_t* srow = x2s + (size_t)r * DM + nt * 256 + wc * 64 + 4 * fq; float ss = 0.f;
                    u32x2 xwv[4];
#pragma unroll
                    for (int n = 0; n < 4; ++n) xwv[n] = *(const u32x2*)(xrow + n * 16);
                    asm volatile("s_waitcnt vmcnt(0)" ::: "memory");
#pragma unroll
                    for (int n = 0; n < 4; ++n) { const u32x2 xw = xwv[n]; f32x4 v = acc[m][n]; v[0] += bflo(xw.x); v[1] += bfhi(xw.x); v[2] += bflo(xw.y); v[3] += bfhi(xw.y);
                        u32x2 w; w.x = cvt_pk_bf16(v[0], v[1]); w.y = cvt_pk_bf16(v[2], v[3]); *(u32x2*)(srow + n * 16) = w; ss += v[0] * v[0] + v[1] * v[1] + v[2] * v[2] + v[3] * v[3]; }
                    ssr[m] += ss;
                }
                asm volatile("" ::: "memory");
            }
        }
#pragma unroll
        for (int m = 0; m < 5; ++m) if (m < 4 || wr == 0) {
            float ss = ssr[m]; ss += __shfl_xor(ss, 16); ss += __shfl_xor(ss, 32);
            if (fq == 0) sspart[(rowbase + m * 16 + fr) * 4 + wc] = ss;
        }
        }
        __syncthreads();
        { asm volatile("" : "+v"(tid)); const int lane = tid & 63, fr = lane & 15, fq = lane >> 4;
#pragma unroll 1
        for (int nt = 0; nt < 4; ++nt)
#pragma unroll
            for (int m = 0; m < 5; ++m) if (m < 4 || wr == 0) {
                const int r = rowbase + m * 16 + fr;
                if (r < nvalid) {
                    const float tsum = (sspart[r * 4] + sspart[r * 4 + 1]) + (sspart[r * 4 + 2] + sspart[r * 4 + 3]);
                    const float rs3 = rsqrtf(tsum * (1.0f / DM) + EPSV);
                    float* orow = P.out + (size_t)rowtok[r] * DM + nt * 256 + wc * 64 + 4 * fq; const bf16_t* srow = x2s + (size_t)r * DM + nt * 256 + wc * 64 + 4 * fq;
                    f32x4 gv[4]; u32x2 xwv[4];
#pragma unroll
                    for (int n = 0; n < 4; ++n) { gv[n] = *(const f32x4*)(P.norm_final + nt * 256 + wc * 64 + 4 * fq + n * 16); xwv[n] = *(const u32x2*)(srow + n * 16); }
                    asm volatile("s_waitcnt vmcnt(0)" ::: "memory");
#pragma unroll
                    for (int n = 0; n < 4; ++n) { const f32x4 g = gv[n]; const u32x2 xw = xwv[n];
                        f32x4 v; v[0] = bflo(xw.x) * rs3 * g[0]; v[1] = bfhi(xw.x) * rs3 * g[1]; v[2] = bflo(xw.y) * rs3 * g[2]; v[3] = bfhi(xw.y) * rs3 * g[3]; __builtin_nontemporal_store(v, (f32x4*)(orow + n * 16)); }
                }
                asm volatile("" ::: "memory");
            }
        }
    }
}


static void fill_params(Params& P, void* const* d_in, void* d_out, void* d_ws) {
    memset(&P, 0, sizeof(P));
    P.x = (const float*)d_in[0]; P.norm_mix = (const float*)d_in[1]; P.w_in = (const float*)d_in[2]; P.pool_w = (const float*)d_in[3]; P.pool_scale = (const float*)d_in[4];
    P.a_re = (const float*)d_in[5]; P.a_im = (const float*)d_in[6]; P.log_step = (const float*)d_in[7]; P.b_re = (const float*)d_in[8]; P.b_im = (const float*)d_in[9];
    P.c_re = (const float*)d_in[10]; P.c_im = (const float*)d_in[11]; P.ssm_d = (const float*)d_in[12]; P.glu_w = (const float*)d_in[13]; P.glu_b = (const float*)d_in[14];
    P.w_out = (const float*)d_in[15]; P.norm_ffn = (const float*)d_in[16]; P.rc_w = (const float*)d_in[17]; P.rc_b = (const float*)d_in[18]; P.rf_w = (const float*)d_in[19]; P.rf_b = (const float*)d_in[20];
    P.wg = (const float*)d_in[21]; P.wu = (const float*)d_in[22]; P.wd = (const float*)d_in[23]; P.norm_final = (const float*)d_in[24];
    P.out = (float*)d_out;
    P.ws = (char*)d_ws;
}
#define CTL_BYTES 65536

__global__ void __launch_bounds__(NTHR) mk_forward(Params P) {
    extern __shared__ __attribute__((aligned(16))) unsigned char lds_raw[];
    LAS unsigned char* lds = (LAS unsigned char*)lds_raw;
    const int bid = blockIdx.x, nblk = gridDim.x; int tid = threadIdx.x;
#define OPAQUE_TID() asm volatile("" : "+v"(tid))
    volatile LAS unsigned* xb_st = (volatile LAS unsigned*)(lds + LDS_BYTES - 16);
    if (tid < 4) xb_st[tid] = 0u;
    __syncthreads();
    const XcdBarrier xb = xcd_barrier_post(P.ctl(), xb_st);
    OPAQUE_TID();
    phase0_x(P, bid, nblk, tid);
    phase0_ssm(P, bid, nblk, tid);
    phase0_weights(P, bid, nblk, tid, (LAS float*)lds);
    xcd_barrier(xb);
    OPAQUE_TID();
    phaseA(P, lds, bid, nblk, tid);
    xcd_barrier(xb);
    OPAQUE_TID();
    phaseA2(P, bid, nblk, tid);
    xcd_barrier(xb);
    for (int c = bid; c < T_TOK / 128; c += nblk) {
        __syncthreads();
        OPAQUE_TID();
        phaseB_ssm(P, lds, c, tid);
        __syncthreads();
        OPAQUE_TID();
        phaseB_pool(P, c, tid);
        OPAQUE_TID();
        phaseB_glu(P, lds, c, tid);
        OPAQUE_TID();
        phaseB_wout(P, lds, c, tid);
        OPAQUE_TID();
        phaseB_router(P, lds, c, tid);
    }
    xcd_barrier(xb);
    OPAQUE_TID();
    phaseC(P, lds, bid, nblk, tid);
}

extern "C" void kernel_launch(void* const* d_in, const int* in_sizes, int n_in, void* d_out, int out_size, void* d_ws, size_t ws_size, hipStream_t stream) {
    static int grid_blocks = 0;
    if (!grid_blocks) {
        int dev = 0, cus = 0, per_cu = 0;
        (void)hipGetDevice(&dev);
        (void)hipDeviceGetAttribute(&cus, hipDeviceAttributeMultiprocessorCount, dev);
        (void)hipFuncSetAttribute((const void*)mk_forward, hipFuncAttributeMaxDynamicSharedMemorySize, LDS_BYTES);
        (void)hipOccupancyMaxActiveBlocksPerMultiprocessor(&per_cu, (const void*)mk_forward, NTHR, LDS_BYTES);
        if (per_cu < 1) per_cu = 1;
        grid_blocks = cus * per_cu; if (grid_blocks > 256) grid_blocks = 256;
    }
    Params P; fill_params(P, d_in, d_out, d_ws);
    (void)hipMemsetAsync(d_ws, 0, CTL_BYTES, stream);
    void* args[] = {&P};
    hipError_t e = hipLaunchCooperativeKernel((const void*)mk_forward, dim3(grid_blocks), dim3(NTHR), args, LDS_BYTES, stream);
    if (e != hipSuccess) fprintf(stderr, "cooperative launch failed: %s (grid %d)\n", hipGetErrorString(e), grid_blocks);
}
```

```cpp
#include <hip/hip_runtime.h>
#include <stdint.h>
#include <string.h>
#include <stdio.h>
#define T_TOK 32768
#define SEQ 8192
#define DM 1024
#define EPSV 1e-6f

#define LAS __attribute__((address_space(3)))
typedef unsigned short bf16_t;
typedef short bf16x8 __attribute__((ext_vector_type(8)));
typedef float f32x4 __attribute__((ext_vector_type(4)));
typedef float f32x16 __attribute__((ext_vector_type(16)));
typedef unsigned u32x2 __attribute__((ext_vector_type(2)));
typedef unsigned u32x4 __attribute__((ext_vector_type(4)));

#define NTHR 512
#define LDS_BYTES 163840
#define STAGE_B 49152
#define MISC_OFF (3 * STAGE_B)

__device__ __forceinline__ unsigned cvt_pk_bf16(float lo, float hi) { unsigned r; asm("v_cvt_pk_bf16_f32 %0, %1, %2" : "=v"(r) : "v"(lo), "v"(hi)); return r; }
__device__ __forceinline__ bf16_t f2bf(float f) { return (bf16_t)(cvt_pk_bf16(f, 0.f) & 0xffffu); }
__device__ __forceinline__ float bf2f(bf16_t h) { return __uint_as_float(((unsigned)h) << 16); }
__device__ __forceinline__ float bflo(unsigned w) { return __uint_as_float(w << 16); }
__device__ __forceinline__ float bfhi(unsigned w) { return __uint_as_float(w & 0xffff0000u); }

struct StagePtrs { const char* a[3]; const char* b[4]; long bdelta; int ksplit; int kt0; int nkt; };

__device__ __forceinline__ int stage_row_a(int wid, int lane, int i) { return (i < 2 ? (wid * 2 + i) * 8 : 128 + wid * 8) + (lane >> 3); }
__device__ __forceinline__ int stage_row_b(int wid, int lane, int i) { return (wid * 4 + i) * 8 + (lane >> 3); }
__device__ __forceinline__ int stage_chunk_off(int row, int lane) { return (((lane & 7) ^ ((row >> 1) & 7)) << 4); }

template <int MF0>
__device__ __forceinline__ void stage_issue(LAS unsigned char* lds, int s, const StagePtrs& sp, int kt_, int wid) {
    constexpr int ABYTES = (64 + 16 * MF0) * 128, SB = ABYTES + 32768;
    LAS unsigned char* base = lds + s * SB;
    int kt = kt_ + sp.kt0; kt = (kt >= sp.nkt) ? kt - sp.nkt : kt;
#pragma unroll
    for (int i = 0; i < 2; ++i) __builtin_amdgcn_global_load_lds((const unsigned*)(sp.a[i] + (size_t)kt * 128), (LAS unsigned*)(base + (wid * 2 + i) * 1024), 16, 0, 0);
    if (MF0 == 5 && wid < 2) __builtin_amdgcn_global_load_lds((const unsigned*)(sp.a[2] + (size_t)kt * 128), (LAS unsigned*)(base + (16 + wid) * 1024), 16, 0, 0);
    const long bofs = (kt < sp.ksplit) ? (long)kt * 128 : (long)(kt - sp.ksplit) * 128 + sp.bdelta;
#pragma unroll
    for (int i = 0; i < 4; ++i) __builtin_amdgcn_global_load_lds((const unsigned*)(sp.b[i] + bofs), (LAS unsigned*)(base + ABYTES + (wid * 4 + i) * 1024), 16, 0, 0);
}

struct NoPre { __device__ __forceinline__ void operator()() const {} };
#define GC_BAR() do { asm volatile("s_waitcnt lgkmcnt(0)" ::: "memory"); __builtin_amdgcn_s_barrier(); asm volatile("" ::: "memory"); } while (0)
#define GC_WAIT1() do { if (extra) asm volatile("s_waitcnt vmcnt(7)" ::: "memory"); else asm volatile("s_waitcnt vmcnt(6)" ::: "memory"); } while (0)
template <int MF0, int MODE, int NPRE, int NPRE1, class Pre>
__device__ __forceinline__ void gemm_ktile(LAS unsigned char* lds, const StagePtrs& sp, int nkt, int kt, int s, f32x4 (&acc)[MF0][4], int wid, int wr, int aoff, int boff, int offk0, int offk1, bool extra, Pre& pre) {
    constexpr int ABYTES = (64 + 16 * MF0) * 128, SB = ABYTES + 32768;
    if (MODE == 0) { if (kt + 2 < nkt) { const int s2 = (s >= 1) ? s - 1 : 2; stage_issue<MF0>(lds, s2, sp, kt + 2, wid); } }
    const LAS unsigned char* st = lds + s * SB;
    bf16x8 af[2][MF0], bfr[2][4];
#pragma unroll
    for (int ks = 0; ks < 2; ++ks) {
        const int ok = ks ? offk1 : offk0;
#pragma unroll
        for (int m = 0; m < MF0; ++m) if (m < 4 || wr == 0) af[ks][m] = *(const LAS bf16x8*)(st + aoff + m * 2048 + ok);
#pragma unroll
        for (int n = 0; n < 4; ++n) bfr[ks][n] = *(const LAS bf16x8*)(st + boff + n * 2048 + ok);
    }
    if (MODE == 0) { if (kt + 2 < nkt) GC_WAIT1(); else asm volatile("s_waitcnt vmcnt(0)" ::: "memory"); }
    if (MODE == 1) { pre(); if (NPRE1 != NPRE && wr == 1) asm volatile("s_waitcnt vmcnt(%0)" :: "n"(NPRE1) : "memory"); else asm volatile("s_waitcnt vmcnt(%0)" :: "n"(NPRE) : "memory"); }
    GC_BAR();
    __builtin_amdgcn_s_setprio(1);
#pragma unroll
    for (int ks = 0; ks < 2; ++ks)
#pragma unroll
        for (int m = 0; m < MF0; ++m) if (m < 4 || wr == 0) {
#pragma unroll
            for (int n = 0; n < 4; ++n) acc[m][n] = __builtin_amdgcn_mfma_f32_16x16x32_bf16(bfr[ks][n], af[ks][m], acc[m][n], 0, 0, 0); }
    __builtin_amdgcn_s_setprio(0);
    GC_BAR();
}
template <int MF0, int NPRE = 0, class Pre = NoPre, int NPRE1 = NPRE>
__device__ __forceinline__ void gemm_core(LAS unsigned char* lds, const StagePtrs& sp, int nkt, f32x4 (&acc)[MF0][4], int wid, int wr, int wc, int lane, bool drain = true, Pre pre = Pre()) {
    constexpr int ABYTES = (64 + 16 * MF0) * 128;
    const int fr = lane & 15, fq = lane >> 4, sw = fr >> 1;
    const int offk0 = fr * 128 + ((fq ^ sw) << 4), offk1 = fr * 128 + (((4 + fq) ^ sw) << 4);
    const int aoff = wr * (MF0 * 2048), boff = ABYTES + wc * 8192;
    const bool extra = (MF0 == 5) && (wid < 2);
    if (drain) asm volatile("s_waitcnt vmcnt(0)" ::: "memory");
    GC_BAR();
    stage_issue<MF0>(lds, 0, sp, 0, wid);
    if (nkt > 1) stage_issue<MF0>(lds, 1, sp, 1, wid);
    if (nkt > 1 && drain) GC_WAIT1(); else asm volatile("s_waitcnt vmcnt(0)" ::: "memory");
    GC_BAR();
    if (wr == 1) GC_BAR();
    int s = 0;
    const int nloop = NPRE > 0 ? nkt - 2 : nkt;
#pragma unroll 1
    for (int kt = 0; kt < nloop; ++kt) {
        gemm_ktile<MF0, 0, NPRE, NPRE1, Pre>(lds, sp, nkt, kt, s, acc, wid, wr, aoff, boff, offk0, offk1, extra, pre);
        s = (s == 2) ? 0 : s + 1;
    }
    if (NPRE > 0) {
        gemm_ktile<MF0, 1, NPRE, NPRE1, Pre>(lds, sp, nkt, nkt - 2, s, acc, wid, wr, aoff, boff, offk0, offk1, extra, pre);
        s = (s == 2) ? 0 : s + 1;
        gemm_ktile<MF0, 2, NPRE, NPRE1, Pre>(lds, sp, nkt, nkt - 1, s, acc, wid, wr, aoff, boff, offk0, offk1, extra, pre);
    }
    if (wr == 0) GC_BAR();
}
#undef GC_BAR
#undef GC_WAIT1
template <int MF0>
__device__ __forceinline__ void acc_zero(f32x4 (&acc)[MF0][4]) {
#pragma unroll
    for (int m = 0; m < MF0; ++m)
#pragma unroll
        for (int n = 0; n < 4; ++n) acc[m][n] = (f32x4){0.f, 0.f, 0.f, 0.f};
}


#define XB_TMO      128
#define XB_XCNT(j)  (256  + 64 * (j))
#define XB_XSUB(j)  (1280 + 64 * (j))
#define XB_XGEN(j)  (2304 + 64 * (j))
#define XB_TOP      3328
#define XB_TOPGEN   3392
#define XCD_BAR_WORDS 3456
#define XB_SPIN_CAP (1u << 18)

__device__ __forceinline__ unsigned xb_ld(unsigned* p)              { return __hip_atomic_load(p, __ATOMIC_RELAXED, __HIP_MEMORY_SCOPE_AGENT); }
__device__ __forceinline__ unsigned xb_add(unsigned* p, unsigned v) { return __hip_atomic_fetch_add(p, v, __ATOMIC_RELAXED, __HIP_MEMORY_SCOPE_AGENT); }
__device__ __forceinline__ unsigned xb_xcc_id() { return (unsigned)__builtin_amdgcn_s_getreg((3 << 11) | 20) & 0xFu; }
#define XB_SPIN(cond, bar) do { unsigned _sp = 0; while (cond) { __builtin_amdgcn_s_sleep(1); \
    if ((++_sp & 255u) == 0u) { if (xb_ld(&(bar)[XB_TMO])) break; if (_sp > XB_SPIN_CAP) { atomicAdd(&(bar)[XB_TMO], 1u); break; } } } } while (0)

struct XcdBarrier {
    unsigned* bar; unsigned x;
    volatile LAS unsigned* st;
};

__device__ __forceinline__ XcdBarrier xcd_barrier_post(unsigned* bar, volatile LAS unsigned* st) {
    XcdBarrier b; b.bar = bar; b.x = xb_xcc_id(); b.st = st;
    if (threadIdx.x == 0) (void)xb_add(&bar[XB_XCNT(b.x)], 1u);
    return b;
}
__device__ __forceinline__ void xcd_barrier_complete(unsigned* bar, unsigned x, unsigned& nloc, unsigned& nx) {
    const unsigned G = gridDim.x * gridDim.y * gridDim.z;
    unsigned sum, cnt, mine, sp = 0u;
    for (;;) {
        sum = 0u; cnt = 0u; mine = 0u;
#pragma unroll
        for (unsigned j = 0; j < 16; ++j) { const unsigned c = xb_ld(&bar[XB_XCNT(j)]); sum += c; cnt += (c > 0u) ? 1u : 0u; mine = (j == x) ? c : mine; }
        if (sum == G) break;
        __builtin_amdgcn_s_sleep(1);
        if ((++sp & 255u) == 0u) { if (xb_ld(&bar[XB_TMO])) break; if (sp > XB_SPIN_CAP) { atomicAdd(&bar[XB_TMO], 1u); break; } }
    }
    nloc = mine > 0u ? mine : 1u; nx = cnt > 0u ? cnt : 1u;
}

__device__ __forceinline__ void xcd_barrier(const XcdBarrier& b) {
    asm volatile("s_waitcnt vmcnt(0)" ::: "memory");
    __syncthreads();
    if (threadIdx.x == 0) {
        unsigned* bar = b.bar;
        __builtin_amdgcn_s_waitcnt(0);
        unsigned nloc = b.st[0], nx = b.st[1];
        if (nloc == 0u) { xcd_barrier_complete(bar, b.x, nloc, nx); b.st[0] = nloc; b.st[1] = nx; }
        const unsigned old = xb_add(&bar[XB_XSUB(b.x)], 1u);
        const unsigned gen = old / nloc;
        if (old + 1u == (gen + 1u) * nloc) {
            __builtin_amdgcn_fence(__ATOMIC_RELEASE, "agent");
            asm volatile("s_waitcnt vmcnt(0)" ::: "memory");
            const unsigned og = xb_add(&bar[XB_TOP], 1u);
            const unsigned tg = og / nx;
            if (og + 1u == (tg + 1u) * nx) xb_add(&bar[XB_TOPGEN], 1u);
            else XB_SPIN(xb_ld(&bar[XB_TOPGEN]) == tg, bar);
            __builtin_amdgcn_fence(__ATOMIC_ACQUIRE, "agent");
            xb_add(&bar[XB_XGEN(b.x)], 1u);
            asm volatile("s_waitcnt vmcnt(0)" ::: "memory");
        } else {
            XB_SPIN(xb_ld(&bar[XB_XGEN(b.x)]) == gen, bar);
            __builtin_amdgcn_fence(__ATOMIC_ACQUIRE, "agent");
            asm volatile("s_waitcnt vmcnt(0)" ::: "memory");
        }
    }
    __syncthreads();
}


struct Params {
    const float* x; const float* norm_mix; const float* w_in; const float* pool_w; const float* pool_scale;
    const float* a_re; const float* a_im; const float* log_step; const float* b_re; const float* b_im; const float* c_re; const float* c_im; const float* ssm_d;
    const float* glu_w; const float* glu_b; const float* w_out; const float* norm_ffn; const float* rc_w; const float* rc_b; const float* rf_w; const float* rf_b;
    const float* wg; const float* wu; const float* wd; const float* norm_final;
    float* out;
    char* ws;
#define WS_MB(x) ((size_t)(x) << 20)
    __device__ __forceinline__ unsigned* ctl() const { return (unsigned*)ws; }
    __device__ __forceinline__ float* rstd1() const { return (float*)(ws + WS_MB(1)); }
    __device__ __forceinline__ float* rstd2() const { return (float*)(ws + WS_MB(1) + 131072); }
    __device__ __forceinline__ float* tokw() const { return (float*)(ws + WS_MB(1) + 262144); }
    __device__ __forceinline__ float* abar() const { return (float*)(ws + WS_MB(2)); }
    __device__ __forceinline__ float* a64() const { return (float*)(ws + WS_MB(2) + 16384); }
    __device__ __forceinline__ float* a128() const { return (float*)(ws + WS_MB(2) + 32768); }
    __device__ __forceinline__ bf16_t* bbT() const { return (bf16_t*)(ws + WS_MB(2) + 65536); }
    __device__ __forceinline__ bf16_t* cmT() const { return (bf16_t*)(ws + WS_MB(2) + 65536 + 131072); }
    __device__ __forceinline__ bf16_t* wrT() const { return (bf16_t*)(ws + WS_MB(3)); }
    __device__ __forceinline__ float* send0() const { return (float*)(ws + WS_MB(4)); }
    __device__ __forceinline__ float* send128() const { return (float*)(ws + WS_MB(8)); }
    __device__ __forceinline__ int* perm() const { return (int*)(ws + WS_MB(12)); }
    __device__ __forceinline__ bf16_t* w_inT() const { return (bf16_t*)(ws + WS_MB(16)); }
    __device__ __forceinline__ bf16_t* gluT() const { return (bf16_t*)(ws + WS_MB(18)); }
    __device__ __forceinline__ bf16_t* w_outT() const { return (bf16_t*)(ws + WS_MB(19)); }
    __device__ __forceinline__ bf16_t* wguT() const { return (bf16_t*)(ws + WS_MB(24)); }
    __device__ __forceinline__ bf16_t* wdT() const { return (bf16_t*)(ws + WS_MB(40)); }
    __device__ __forceinline__ bf16_t* hid() const { return (bf16_t*)(ws + WS_MB(48)); }
    __device__ __forceinline__ bf16_t* xb() const { return (bf16_t*)(ws + WS_MB(96)); }
    __device__ __forceinline__ bf16_t* z() const { return (bf16_t*)(ws + WS_MB(160)); }
    __device__ __forceinline__ bf16_t* ycat() const { return (bf16_t*)(ws + WS_MB(224)); }
    __device__ __forceinline__ bf16_t* x1b() const { return (bf16_t*)(ws + WS_MB(288)); }
    __device__ __forceinline__ bf16_t* ybuf() const { return (bf16_t*)(ws + WS_MB(352)); }
};

__device__ __forceinline__ void phase0_x(const Params& P, int bid, int nblk, int tid) {
    const int wave = tid >> 6, lane = tid & 63;
    for (int row = (bid * 8 + wave) * 4; row < T_TOK; row += nblk * 32) {
        f32x4 v[4][4];
#pragma unroll
        for (int r = 0; r < 4; ++r)
#pragma unroll
            for (int i = 0; i < 4; ++i) v[r][i] = __builtin_nontemporal_load((const f32x4*)(P.x + (size_t)(row + r) * DM + i * 256 + lane * 4));
        asm volatile("s_waitcnt vmcnt(0)" ::: "memory");
#pragma unroll
        for (int r = 0; r < 4; ++r) {
            float s = 0.f;
#pragma unroll
            for (int i = 0; i < 4; ++i) s += v[r][i][0] * v[r][i][0] + v[r][i][1] * v[r][i][1] + v[r][i][2] * v[r][i][2] + v[r][i][3] * v[r][i][3];
#pragma unroll
            for (int o = 32; o > 0; o >>= 1) s += __shfl_xor(s, o);
            if (lane == 0) P.rstd1()[row + r] = rsqrtf(s * (1.0f / DM) + EPSV);
            bf16_t* xo = P.xb() + (size_t)(row + r) * DM;
#pragma unroll
            for (int i = 0; i < 4; ++i) { u32x2 w; w.x = cvt_pk_bf16(v[r][i][0], v[r][i][1]); w.y = cvt_pk_bf16(v[r][i][2], v[r][i][3]); *(u32x2*)(xo + i * 256 + lane * 4) = w; }
        }
    }
}

struct TrJob { const float* sa; const float* sb; const float* scale; bf16_t* dst; int lds; int ldd; };
__device__ __forceinline__ void tr_describe(const Params& P, int job, TrJob& J) {
    if (job < 128) { const int n0 = 512 + (job >> 4) * 64, k0 = (job & 15) * 64;
        J.sa = P.w_in + (size_t)k0 * DM + n0; J.sb = J.sa + 32; J.scale = P.norm_mix + k0; J.dst = P.w_inT() + (size_t)n0 * DM + k0; J.lds = DM; J.ldd = DM; }
    else if (job < 192) { const int j = job - 128, n0 = (j >> 3) * 64, k0 = (j & 7) * 64;
        J.sa = P.glu_w + (size_t)k0 * 512 + n0; J.sb = J.sa + 32; J.scale = nullptr; J.dst = P.gluT() + (size_t)n0 * 512 + k0; J.lds = 512; J.ldd = 512; }
    else if (job < 448) { const int j = job - 192, n0 = (j >> 4) * 64, k0 = (j & 15) * 64;
        J.sa = P.w_out + (size_t)k0 * DM + n0; J.sb = J.sa + 32; J.scale = nullptr; J.dst = P.w_outT() + (size_t)n0 * DM + k0; J.lds = DM; J.ldd = DM; }
    else if (job < 2496) { const int j = job - 448, kt = j & 15, wc = (j >> 4) & 3, ch = (j >> 6) & 1, e = j >> 7, k0 = kt * 64, f0 = 128 * ch + 32 * wc;
        J.sa = P.wg + ((size_t)e * DM + k0) * 256 + f0; J.sb = P.wu + ((size_t)e * DM + k0) * 256 + f0; J.scale = P.norm_ffn + k0;
        J.dst = P.wguT() + ((size_t)((e * 2 + ch) * 256 + wc * 64)) * DM + k0; J.lds = 256; J.ldd = DM; }
    else { const int j = job - 2496, ft = j & 3, nt = (j >> 2) & 15, e = j >> 6, f0 = ft * 64, n0 = nt * 64;
        J.sa = P.wd + ((size_t)e * 256 + f0) * DM + n0; J.sb = J.sa + 32; J.scale = nullptr; J.dst = P.wdT() + ((size_t)e * DM + n0) * 256 + f0; J.lds = DM; J.ldd = 256; }
}
__device__ __forceinline__ void tr_round(const Params& P, int job0, int jstep, int njobs_end, LAS float* tl, int tid) {
    TrJob J[4]; f32x4 a[4], b[4]; float sc[4];
    const int k = tid >> 3, c8 = (tid & 7) * 8;
#pragma unroll
    for (int q = 0; q < 4; ++q) { const int job = job0 + q * jstep; if (job < njobs_end) { tr_describe(P, job, J[q]);
        const float* src = (c8 < 32 ? J[q].sa + c8 : J[q].sb + (c8 - 32)) + (size_t)k * J[q].lds;
        a[q] = __builtin_nontemporal_load((const f32x4*)src); b[q] = __builtin_nontemporal_load((const f32x4*)(src + 4));
        sc[q] = J[q].scale ? J[q].scale[k] : 1.0f; } }
    asm volatile("s_waitcnt vmcnt(0)" ::: "memory");
#pragma unroll
    for (int q = 0; q < 4; ++q) if (job0 + q * jstep < njobs_end) { LAS float* t = tl + q * (64 * 65) + k * 65 + c8;
        t[0] = a[q][0] * sc[q]; t[1] = a[q][1] * sc[q]; t[2] = a[q][2] * sc[q]; t[3] = a[q][3] * sc[q]; t[4] = b[q][0] * sc[q]; t[5] = b[q][1] * sc[q]; t[6] = b[q][2] * sc[q]; t[7] = b[q][3] * sc[q]; }
    __syncthreads();
    const int n = tid >> 3, k8 = (tid & 7) * 8;
#pragma unroll
    for (int q = 0; q < 4; ++q) if (job0 + q * jstep < njobs_end) { const LAS float* t = tl + q * (64 * 65);
        u32x4 w;
        w.x = cvt_pk_bf16(t[(k8 + 0) * 65 + n], t[(k8 + 1) * 65 + n]); w.y = cvt_pk_bf16(t[(k8 + 2) * 65 + n], t[(k8 + 3) * 65 + n]);
        w.z = cvt_pk_bf16(t[(k8 + 4) * 65 + n], t[(k8 + 5) * 65 + n]); w.w = cvt_pk_bf16(t[(k8 + 6) * 65 + n], t[(k8 + 7) * 65 + n]);
        *(u32x4*)(J[q].dst + (size_t)n * J[q].ldd + k8) = w; }
    __syncthreads();
}

#define N_TR_JOBS 3648
__device__ __forceinline__ void phase0_weights(const Params& P, int bid, int nblk, int tid, LAS float* tl) {
    for (int job = bid; job < 3520; job += 4 * nblk) tr_round(P, job, nblk, 3520, tl, tid);
    for (int job = 3520 + bid; job < N_TR_JOBS; job += nblk) {
        {
            const int j = job - 3520, n0 = (j >> 4) * 64, k0 = (j & 15) * 64, g = n0 >> 7, d0 = n0 & 127;
            LAS float* wa = tl + 64 * 65;
            LAS float* pb = wa + 64 * 129;
            for (int i = tid; i < 64 * 32; i += NTHR) { const int k = i >> 5, c4 = (i & 31) * 4; const f32x4 v = *(const f32x4*)(P.w_in + (size_t)(k0 + k) * DM + 128 * g + c4);
                LAS float* t = wa + k * 129 + c4; t[0] = v[0]; t[1] = v[1]; t[2] = v[2]; t[3] = v[3]; }
            for (int i = tid; i < 128 * 16; i += NTHR) { const int cc = i >> 4, d4 = (i & 15) * 4; const f32x4 v = *(const f32x4*)(P.pool_w + ((size_t)g * 128 + cc) * 128 + d0 + d4);
                LAS float* t = pb + cc * 65 + d4; t[0] = v[0]; t[1] = v[1]; t[2] = v[2]; t[3] = v[3]; }
            __syncthreads();
            {
                const int k = tid >> 3, dl = tid & 7; float a[8];
#pragma unroll
                for (int q = 0; q < 8; ++q) a[q] = 0.f;
                for (int cc = 0; cc < 128; ++cc) { const float wv = wa[k * 129 + cc];
#pragma unroll
                    for (int q = 0; q < 8; ++q) a[q] += wv * pb[cc * 65 + dl + 8 * q]; }
                const float nm = P.norm_mix[k0 + k];
#pragma unroll
                for (int q = 0; q < 8; ++q) tl[k * 65 + dl + 8 * q] = a[q] * nm * P.pool_scale[n0 + dl + 8 * q];
            }
            __syncthreads();
            { const int n = tid >> 3, k8 = (tid & 7) * 8; u32x4 w;
              w.x = cvt_pk_bf16(tl[(k8 + 0) * 65 + n], tl[(k8 + 1) * 65 + n]); w.y = cvt_pk_bf16(tl[(k8 + 2) * 65 + n], tl[(k8 + 3) * 65 + n]);
              w.z = cvt_pk_bf16(tl[(k8 + 4) * 65 + n], tl[(k8 + 5) * 65 + n]); w.w = cvt_pk_bf16(tl[(k8 + 6) * 65 + n], tl[(k8 + 7) * 65 + n]);
              *(u32x4*)(P.w_inT() + (size_t)(n0 + n) * DM + k0 + k8) = w; }
            __syncthreads();
        }
    }
    for (int i = bid * NTHR + tid; i < 32 * DM; i += nblk * NTHR) {
        const int j = i >> 10, k = i & 1023; float v = 0.f;
        if (j < 4) v = P.norm_ffn[k] * P.rc_w[k * 4 + j]; else if (j < 20) v = P.norm_ffn[k] * P.rf_w[k * 16 + j - 4];
        P.wrT()[i] = f2bf(v);
    }
}

__device__ __forceinline__ void phaseA(const Params& P, LAS unsigned char* lds, int bid, int nblk, int tid) {
    const int wid = __builtin_amdgcn_readfirstlane(tid >> 6), lane = tid & 63, wr = wid >> 2, wc = wid & 3, fr = lane & 15, fq = lane >> 4;
    for (int u = bid; u < 1024; u += nblk) {
        const int i = u / nblk, b = u % nblk;
        int mt, nt;
        if (nblk == 256) { const int xcd = b & 7, idx = b >> 3; mt = (i * 8 + xcd) * 8 + (idx >> 2); nt = idx & 3; } else { mt = u >> 2; nt = u & 3; }
        StagePtrs sp; sp.a[2] = nullptr; sp.ksplit = 1 << 30; sp.bdelta = 0; sp.kt0 = 0; sp.nkt = 1 << 30;
#pragma unroll
        for (int j = 0; j < 2; ++j) { const int r = stage_row_a(wid, lane, j); sp.a[j] = (const char*)(P.xb() + (size_t)(mt * 128 + r) * DM) + stage_chunk_off(r, lane); }
#pragma unroll
        for (int j = 0; j < 4; ++j) { const int r = stage_row_b(wid, lane, j); sp.b[j] = (const char*)(P.w_inT() + (size_t)(nt * 256 + r) * DM) + stage_chunk_off(r, lane); }
        f32x4 acc[4][4]; acc_zero<4>(acc);
        gemm_core<4>(lds, sp, DM / 64, acc, wid, wr, wc, lane, false);
        float rsm[4];
#pragma unroll
        for (int m = 0; m < 4; ++m) rsm[m] = P.rstd1()[mt * 128 + wr * 64 + m * 16 + fr];
        asm volatile("s_waitcnt vmcnt(0)" ::: "memory");
#pragma unroll
        for (int m = 0; m < 4; ++m) {
            const int row = mt * 128 + wr * 64 + m * 16 + fr; const float rs = rsm[m];
            bf16_t* zr = P.z() + (size_t)row * DM + nt * 256 + wc * 64 + 4 * fq;
#pragma unroll
            for (int n = 0; n < 4; ++n) { u32x2 w; w.x = cvt_pk_bf16(acc[m][n][0] * rs, acc[m][n][1] * rs); w.y = cvt_pk_bf16(acc[m][n][2] * rs, acc[m][n][3] * rs); *(u32x2*)(zr + n * 16) = w; }
        }
    }
}


__device__ __forceinline__ void phase0_ssm(const Params& P, int bid, int nblk, int tid) {
    for (int i = bid * NTHR + tid; i < 2048; i += nblk * NTHR) {
        const int g = i >> 6;
        const double lr = (double)P.a_re[i], li = (double)P.a_im[i], step = exp((double)P.log_step[g]);
        const double mag = exp(lr * step), ar = mag * cos(li * step), ai = mag * sin(li * step);
        const double den = lr * lr + li * li, nr = ar - 1.0, ni = ai;
        const double qr = (nr * lr + ni * li) / den, qi = (ni * lr - nr * li) / den;
        P.abar()[2 * i] = (float)ar; P.abar()[2 * i + 1] = (float)ai;
        const double m64 = exp(64.0 * lr * step), m128 = exp(128.0 * lr * step);
        P.a64()[2 * i] = (float)(m64 * cos(64.0 * li * step)); P.a64()[2 * i + 1] = (float)(m64 * sin(64.0 * li * step));
        P.a128()[2 * i] = (float)(m128 * cos(128.0 * li * step)); P.a128()[2 * i + 1] = (float)(m128 * sin(128.0 * li * step));
        const int p = i & 63;
        float brv[16], biv[16];
#pragma unroll
        for (int h = 0; h < 16; ++h) { brv[h] = P.b_re[i * 16 + h]; biv[h] = P.b_im[i * 16 + h]; }
        asm volatile("s_waitcnt vmcnt(0)" ::: "memory");
#pragma unroll
        for (int h = 0; h < 16; ++h) {
            const double br = (double)brv[h], bi = (double)biv[h];
            P.bbT()[((size_t)g * 128 + p) * 16 + h] = f2bf((float)(qr * br - qi * bi));
            P.bbT()[((size_t)g * 128 + 64 + p) * 16 + h] = f2bf((float)(qr * bi + qi * br));
        }
    }
    for (int i = bid * NTHR + tid; i < 32 * 16 * 160; i += nblk * NTHR) {
        const int k = i % 160, gh = i / 160, h = gh & 15;
        float v = 0.f;
        if (k < 128) v = (k & 1) ? -P.c_im[gh * 64 + (k >> 1)] : P.c_re[gh * 64 + (k >> 1)];
        else if (k - 128 == h) v = P.ssm_d[gh];
        P.cmT()[i] = f2bf(v);
    }
}

struct SsmGroup { bf16x8 bop[4]; float ar[2], ai[2]; };
__device__ __forceinline__ void ssm_load_group(const Params& P, int g, int lane, SsmGroup& G) {
#pragma unroll
    for (int cb = 0; cb < 4; ++cb) G.bop[cb] = *(const bf16x8*)(P.bbT() + ((size_t)g * 128 + 32 * cb + (lane & 31)) * 16 + 8 * (lane >> 5));
#pragma unroll
    for (int sp = 0; sp < 2; ++sp) { const int s = g * 64 + 32 * sp + (lane & 31); G.ar[sp] = P.abar()[2 * s]; G.ai[sp] = P.abar()[2 * s + 1]; }
}
__device__ __forceinline__ int ssm_row_token(int lane, int j) { const int r = lane & 31; return 64 * ((r >> 2) & 1) + 16 * j + (r & 3) + 4 * (r >> 3); }

__device__ __forceinline__ void phaseA2(const Params& P, int bid, int nblk, int tid) {
    const int wid = tid >> 6, lane = tid & 63;
    for (int c = bid; c < 256; c += nblk) {
        for (int gi = 0; gi < 4; ++gi) {
            const int g = wid * 4 + gi;
            SsmGroup G; ssm_load_group(P, g, lane, G);
            float xr[2] = {0.f, 0.f}, xi[2] = {0.f, 0.f};
#pragma unroll 1
            for (int j = 0; j < 4; ++j) {
                const int tok = c * 128 + ssm_row_token(lane, j);
                const bf16x8 aop = *(const bf16x8*)(P.z() + (size_t)tok * DM + 512 + 16 * g + 8 * (lane >> 5));
                f32x16 bu[4];
#pragma unroll
                for (int cb = 0; cb < 4; ++cb) { f32x16 zz; for (int q = 0; q < 16; ++q) zz[q] = 0.f; bu[cb] = __builtin_amdgcn_mfma_f32_32x32x16_bf16(aop, G.bop[cb], zz, 0, 0, 0); }
#pragma unroll
                for (int i = 0; i < 16; ++i)
#pragma unroll
                    for (int sp = 0; sp < 2; ++sp) {
                        const float nxr = G.ar[sp] * xr[sp] - G.ai[sp] * xi[sp] + bu[sp][i];
                        const float nxi = G.ar[sp] * xi[sp] + G.ai[sp] * xr[sp] + bu[2 + sp][i];
                        xr[sp] = nxr; xi[sp] = nxi;
                    }
            }
#pragma unroll
            for (int sp = 0; sp < 2; ++sp) {
                const float s1r = __shfl(xr[sp], (lane & 31) + 32), s1i = __shfl(xi[sp], (lane & 31) + 32);
                if (lane < 32) {
                    const int s = g * 64 + 32 * sp + lane;
                    const float pr = P.a64()[2 * s], pi = P.a64()[2 * s + 1];
                    asm volatile("s_waitcnt vmcnt(0)" ::: "memory");
                    const size_t o = ((size_t)c * 2048 + s) * 2;
                    P.send0()[o] = xr[sp]; P.send0()[o + 1] = xi[sp];
                    P.send128()[o] = pr * xr[sp] - pi * xi[sp] + s1r; P.send128()[o + 1] = pr * xi[sp] + pi * xr[sp] + s1i;
                }
            }
        }
    }
}

#define XA_STRIDE 336
__device__ __forceinline__ float gelu_tanh(float y) { const float a = 1.5957691216057308f * (y + 0.044715f * y * y * y); return y / (1.0f + __expf(-a)); }

__device__ __forceinline__ void phaseB_ssm(const Params& P, LAS unsigned char* lds, int c, int tid) {
    const int wid = tid >> 6, lane = tid & 63;
    LAS float* carry = (LAS float*)(lds + 86016);
    {
        const int c0 = c & ~63;
        f32x4 cr0 = {0.f, 0.f, 0.f, 0.f}, cr1 = {0.f, 0.f, 0.f, 0.f};
        const f32x4 p0 = *(const f32x4*)(P.a128() + 8 * tid), p1 = *(const f32x4*)(P.a128() + 8 * tid + 4);
        int cc = c0;
        for (; cc + 8 <= c; cc += 8) {
            f32x4 s0[8], s1[8];
#pragma unroll
            for (int q = 0; q < 8; ++q) { s0[q] = *(const f32x4*)(P.send128() + (size_t)(cc + q) * 4096 + 8 * tid); s1[q] = *(const f32x4*)(P.send128() + (size_t)(cc + q) * 4096 + 8 * tid + 4); }
#pragma unroll
            for (int q = 0; q < 8; ++q) {
                f32x4 n0, n1;
                n0[0] = p0[0] * cr0[0] - p0[1] * cr0[1] + s0[q][0]; n0[1] = p0[0] * cr0[1] + p0[1] * cr0[0] + s0[q][1];
                n0[2] = p0[2] * cr0[2] - p0[3] * cr0[3] + s0[q][2]; n0[3] = p0[2] * cr0[3] + p0[3] * cr0[2] + s0[q][3];
                n1[0] = p1[0] * cr1[0] - p1[1] * cr1[1] + s1[q][0]; n1[1] = p1[0] * cr1[1] + p1[1] * cr1[0] + s1[q][1];
                n1[2] = p1[2] * cr1[2] - p1[3] * cr1[3] + s1[q][2]; n1[3] = p1[2] * cr1[3] + p1[3] * cr1[2] + s1[q][3];
                cr0 = n0; cr1 = n1;
            }
        }
        for (; cc < c; ++cc) {
            const f32x4 s0 = *(const f32x4*)(P.send128() + (size_t)cc * 4096 + 8 * tid), s1 = *(const f32x4*)(P.send128() + (size_t)cc * 4096 + 8 * tid + 4);
            f32x4 n0, n1;
            n0[0] = p0[0] * cr0[0] - p0[1] * cr0[1] + s0[0]; n0[1] = p0[0] * cr0[1] + p0[1] * cr0[0] + s0[1];
            n0[2] = p0[2] * cr0[2] - p0[3] * cr0[3] + s0[2]; n0[3] = p0[2] * cr0[3] + p0[3] * cr0[2] + s0[3];
            n1[0] = p1[0] * cr1[0] - p1[1] * cr1[1] + s1[0]; n1[1] = p1[0] * cr1[1] + p1[1] * cr1[0] + s1[1];
            n1[2] = p1[2] * cr1[2] - p1[3] * cr1[3] + s1[2]; n1[3] = p1[2] * cr1[3] + p1[3] * cr1[2] + s1[3];
            cr0 = n0; cr1 = n1;
        }
        *(LAS f32x4*)(carry + 8 * tid) = cr0; *(LAS f32x4*)(carry + 8 * tid + 4) = cr1;
    }
    LAS unsigned char* XA = lds + wid * (32 * XA_STRIDE);
    if (lane < 32) { const u32x4 zz = {0u, 0u, 0u, 0u}; *(LAS u32x4*)(XA + lane * XA_STRIDE + 288) = zz; *(LAS u32x4*)(XA + lane * XA_STRIDE + 304) = zz; }
    __syncthreads();
    for (int gi = 0; gi < 4; ++gi) {
        const int g = wid * 4 + gi;
        SsmGroup G; ssm_load_group(P, g, lane, G);
        bf16x8 cf[5];
#pragma unroll
        for (int ks = 0; ks < 5; ++ks) cf[ks] = *(const bf16x8*)(P.cmT() + ((size_t)g * 16 + (lane & 15)) * 160 + 32 * ks + 8 * (lane >> 4));
        float xr[2], xi[2];
#pragma unroll
        for (int sp = 0; sp < 2; ++sp) {
            const int s = g * 64 + 32 * sp + (lane & 31);
            const float c0r = carry[2 * s], c0i = carry[2 * s + 1];
            if (lane < 32) { xr[sp] = c0r; xi[sp] = c0i; }
            else { const float pr = P.a64()[2 * s], pi = P.a64()[2 * s + 1]; const size_t o = ((size_t)c * 2048 + s) * 2;
                   xr[sp] = pr * c0r - pi * c0i + P.send0()[o]; xi[sp] = pr * c0i + pi * c0r + P.send0()[o + 1]; }
        }
        bf16x8 aops[4];
#pragma unroll
        for (int j = 0; j < 4; ++j) aops[j] = *(const bf16x8*)(P.z() + (size_t)(c * 128 + ssm_row_token(lane, j)) * DM + 512 + 16 * g + 8 * (lane >> 5));
        asm volatile("s_waitcnt vmcnt(0)" ::: "memory");
#pragma unroll
        for (int j = 0; j < 4; ++j) {
            const bf16x8 aop = aops[j];
            f32x16 bu[4];
#pragma unroll
            for (int cb = 0; cb < 4; ++cb) { f32x16 zz; for (int q = 0; q < 16; ++q) zz[q] = 0.f; bu[cb] = __builtin_amdgcn_mfma_f32_32x32x16_bf16(aop, G.bop[cb], zz, 0, 0, 0); }
            { const int r = lane & 31, xrow = 16 * ((r >> 2) & 1) + (r & 3) + 4 * (r >> 3); *(LAS bf16x8*)(XA + xrow * XA_STRIDE + 256 + 16 * (lane >> 5)) = aop; }
            LAS unsigned char* xw = XA + (16 * (lane >> 5)) * XA_STRIDE + 4 * (lane & 31);
#pragma unroll
            for (int i = 0; i < 16; ++i) {
#pragma unroll
                for (int sp = 0; sp < 2; ++sp) {
                    const float nxr = G.ar[sp] * xr[sp] - G.ai[sp] * xi[sp] + bu[sp][i];
                    const float nxi = G.ar[sp] * xi[sp] + G.ai[sp] * xr[sp] + bu[2 + sp][i];
                    xr[sp] = nxr; xi[sp] = nxi;
                    *(LAS unsigned*)(xw + i * XA_STRIDE + 128 * sp) = cvt_pk_bf16(nxr, nxi);
                }
            }
            asm volatile("s_waitcnt lgkmcnt(0)" ::: "memory");
#pragma unroll
            for (int rg = 0; rg < 2; ++rg) {
                f32x4 ay = {0.f, 0.f, 0.f, 0.f};
#pragma unroll
                for (int ks = 0; ks < 5; ++ks) {
                    const bf16x8 xf = *(const LAS bf16x8*)(XA + (16 * rg + (lane & 15)) * XA_STRIDE + 64 * ks + 16 * (lane >> 4));
                    ay = __builtin_amdgcn_mfma_f32_16x16x32_bf16(cf[ks], xf, ay, 0, 0, 0);
                }
                const int tok = c * 128 + 64 * rg + 16 * j + (lane & 15);
                u32x2 w; w.x = cvt_pk_bf16(gelu_tanh(ay[0]), gelu_tanh(ay[1])); w.y = cvt_pk_bf16(gelu_tanh(ay[2]), gelu_tanh(ay[3]));
                *(u32x2*)(P.ybuf() + (size_t)tok * 512 + 16 * g + 4 * (lane >> 4)) = w;
            }
            asm volatile("s_waitcnt lgkmcnt(0)" ::: "memory");
        }
    }
}


template <int W>
__device__ __forceinline__ void pool_channel(const Params& P, int c, int ch) {
    const int t0 = c * 128, pos0 = t0 & (SEQ - 1);
    const bf16_t* zc = P.z() + ch;
    float prev[16], cur[16];
#pragma unroll
    for (int i = 0; i < 16; ++i) prev[i] = (pos0 > 0) ? bf2f(zc[(size_t)(t0 - 16 + i) * DM]) : 0.f;
#pragma unroll 1
    for (int b = 0; b < 8; ++b) {
        const int tb = t0 + 16 * b, posb = pos0 + 16 * b;
#pragma unroll
        for (int i = 0; i < 16; ++i) cur[i] = bf2f(zc[(size_t)(tb + i) * DM]);
        asm volatile("s_waitcnt vmcnt(0)" ::: "memory");
#pragma unroll
        for (int i = 0; i < 16; ++i) {
            float a = 0.f;
#pragma unroll
            for (int j = 0; j < W; ++j) a += (i - j >= 0) ? cur[(i - j >= 0) ? i - j : 0] : prev[(i - j < 0) ? 16 + i - j : 0];
            const int pos = posb + i;
            const float inv = (pos + 1 < W) ? 1.0f / (float)(pos + 1) : (1.0f / (float)W);
            P.ycat()[(size_t)(tb + i) * DM + ch] = f2bf(a * inv - cur[i]);
        }
#pragma unroll
        for (int i = 0; i < 16; ++i) prev[i] = cur[i];
    }
}
__device__ __forceinline__ void phaseB_pool(const Params& P, int c, int tid) {
    const int gi = __builtin_amdgcn_readfirstlane(tid >> 7);
    if (gi == 0) pool_channel<2>(P, c, tid); else if (gi == 1) pool_channel<4>(P, c, tid); else if (gi == 2) pool_channel<8>(P, c, tid); else pool_channel<16>(P, c, tid);
}

__device__ __forceinline__ void phaseB_glu(const Params& P, LAS unsigned char* lds, int c, int tid) {
    const int wid = __builtin_amdgcn_readfirstlane(tid >> 6), lane = tid & 63, wr = wid >> 2, wc = wid & 3, fr = lane & 15, fq = lane >> 4;
#pragma unroll 1
    for (int nt_ = 0; nt_ < 2; ++nt_) {
        const int nt = (nt_ + c) & 1;
        StagePtrs sp; sp.a[2] = nullptr; sp.ksplit = 1 << 30; sp.bdelta = 0; sp.kt0 = (c >> 1) & 7; sp.nkt = 8;
#pragma unroll
        for (int j = 0; j < 2; ++j) { const int r = stage_row_a(wid, lane, j); sp.a[j] = (const char*)(P.ybuf() + (size_t)(c * 128 + r) * 512) + stage_chunk_off(r, lane); }
#pragma unroll
        for (int j = 0; j < 4; ++j) { const int r = stage_row_b(wid, lane, j); sp.b[j] = (const char*)(P.gluT() + (size_t)(nt * 256 + r) * 512) + stage_chunk_off(r, lane); }
        f32x4 acc[4][4]; acc_zero<4>(acc);
        f32x4 bb[4]; u32x2 ywa[4][4];
        const float* bres = P.glu_b + nt * 256 + wc * 64 + 4 * fq;
        const bf16_t* yres = P.ybuf() + ((size_t)c * 128 + wr * 64 + fr) * 512 + nt * 256 + wc * 64 + 4 * fq;
        auto pre = [&]() {
#pragma unroll
            for (int n = 0; n < 4; ++n) bb[n] = *(const f32x4*)(bres + n * 16);
#pragma unroll
            for (int m = 0; m < 4; ++m)
#pragma unroll
                for (int n = 0; n < 4; ++n) ywa[m][n] = *(const u32x2*)(yres + (size_t)m * 16 * 512 + n * 16);
            asm volatile("" ::: "memory");
        };
        gemm_core<4, 20>(lds, sp, 512 / 64, acc, wid, wr, wc, lane, nt_ == 0, pre);
        asm volatile("s_waitcnt vmcnt(0)" ::: "memory");
#pragma unroll
        for (int m = 0; m < 4; ++m) {
            const int row = c * 128 + wr * 64 + m * 16 + fr;
#pragma unroll
            for (int n = 0; n < 4; ++n) {
                const int col = nt * 256 + wc * 64 + n * 16 + 4 * fq;
                const u32x2 ywv = ywa[m][n];
                const float y0 = bflo(ywv.x), y1 = bfhi(ywv.x), y2 = bflo(ywv.y), y3 = bfhi(ywv.y);
                u32x2 w;
                w.x = cvt_pk_bf16(y0 / (1.0f + __expf(-(acc[m][n][0] + bb[n][0]))), y1 / (1.0f + __expf(-(acc[m][n][1] + bb[n][1]))));
                w.y = cvt_pk_bf16(y2 / (1.0f + __expf(-(acc[m][n][2] + bb[n][2]))), y3 / (1.0f + __expf(-(acc[m][n][3] + bb[n][3]))));
                *(u32x2*)(P.ycat() + (size_t)row * DM + 512 + col) = w;
            }
        }
    }
}

__device__ __forceinline__ void phaseB_wout(const Params& P, LAS unsigned char* lds, int c, int tid) {
    const int wid = __builtin_amdgcn_readfirstlane(tid >> 6), lane = tid & 63, wr = wid >> 2, wc = wid & 3, fr = lane & 15, fq = lane >> 4;
    LAS float* rowss = (LAS float*)(lds + MISC_OFF);
    LAS float* sspart = (LAS float*)(lds + MISC_OFF + 1024);
#pragma unroll 1
    for (int nt_ = 0; nt_ < 4; ++nt_) {
        const int nt = nt_;
        StagePtrs sp; sp.a[2] = nullptr; sp.ksplit = 1 << 30; sp.bdelta = 0; sp.kt0 = (c >> 2) & 15; sp.nkt = 16;
#pragma unroll
        for (int j = 0; j < 2; ++j) { const int r = stage_row_a(wid, lane, j); sp.a[j] = (const char*)(P.ycat() + (size_t)(c * 128 + r) * DM) + stage_chunk_off(r, lane); }
#pragma unroll
        for (int j = 0; j < 4; ++j) { const int r = stage_row_b(wid, lane, j); sp.b[j] = (const char*)(P.w_outT() + (size_t)(nt * 256 + r) * DM) + stage_chunk_off(r, lane); }
        f32x4 acc[4][4]; acc_zero<4>(acc);
        u32x2 xw[4][4];
        const bf16_t* xres = P.xb() + ((size_t)c * 128 + wr * 64 + fr) * DM + nt * 256 + wc * 64 + 4 * fq;
        auto pre = [&]() {
#pragma unroll
            for (int m = 0; m < 4; ++m)
#pragma unroll
                for (int n = 0; n < 4; ++n) xw[m][n] = *(const u32x2*)(xres + (size_t)m * 16 * DM + n * 16);
            asm volatile("" ::: "memory");
        };
        gemm_core<4, 16>(lds, sp, DM / 64, acc, wid, wr, wc, lane, nt_ == 0, pre);
        asm volatile("s_waitcnt vmcnt(0)" ::: "memory");
#pragma unroll
        for (int m = 0; m < 4; ++m) {
            const int lrow = wr * 64 + m * 16 + fr; const size_t row = (size_t)c * 128 + lrow;
            float ss = 0.f;
#pragma unroll
            for (int n = 0; n < 4; ++n) {
                const int col = nt * 256 + wc * 64 + n * 16 + 4 * fq;
                f32x4 v = acc[m][n]; v[0] += bflo(xw[m][n].x); v[1] += bfhi(xw[m][n].x); v[2] += bflo(xw[m][n].y); v[3] += bfhi(xw[m][n].y);
                u32x2 w; w.x = cvt_pk_bf16(v[0], v[1]); w.y = cvt_pk_bf16(v[2], v[3]);
                *(u32x2*)(P.x1b() + row * DM + col) = w;
                ss += v[0] * v[0] + v[1] * v[1] + v[2] * v[2] + v[3] * v[3];
            }
            ss += __shfl_xor(ss, 16); ss += __shfl_xor(ss, 32);
            if (fq == 0) sspart[lrow * 16 + nt * 4 + wc] = ss;
        }
    }
    asm volatile("s_waitcnt vmcnt(0)" ::: "memory");
    __syncthreads();
    if (tid < 128) { float t = 0.f;
#pragma unroll
        for (int q = 0; q < 16; ++q) t += sspart[tid * 16 + q];
        const float r = rsqrtf(t * (1.0f / DM) + EPSV); P.rstd2()[c * 128 + tid] = r; rowss[tid] = r; }
    __syncthreads();
}


#define LG_OFF (MISC_OFF + 1024)
#define CNT_OFF (MISC_OFF + 1024 + 10240)
__device__ __forceinline__ void phaseB_router(const Params& P, LAS unsigned char* lds, int c, int tid) {
    const int wid = tid >> 6, lane = tid & 63, l15 = lane & 15, fq = lane >> 4;
    LAS float* rowss = (LAS float*)(lds + MISC_OFF);
    LAS float* lg = (LAS float*)(lds + LG_OFF);
    LAS int* lcnt = (LAS int*)(lds + CNT_OFF);
    if (tid < 48) lcnt[tid] = 0;
    {
        f32x4 a0 = {0.f, 0.f, 0.f, 0.f}, a1 = {0.f, 0.f, 0.f, 0.f};
        const bf16_t* xr = P.x1b() + (size_t)(c * 128 + wid * 16 + l15) * DM + 8 * fq;
        const bf16_t* w0 = P.wrT() + (size_t)l15 * DM + 8 * fq;
        const bf16_t* w1 = P.wrT() + (size_t)(16 + l15) * DM + 8 * fq;
#pragma unroll 8
        for (int ks = 0; ks < 32; ++ks) {
            const bf16x8 xf = *(const bf16x8*)(xr + 32 * ks), f0 = *(const bf16x8*)(w0 + 32 * ks), f1 = *(const bf16x8*)(w1 + 32 * ks);
            a0 = __builtin_amdgcn_mfma_f32_16x16x32_bf16(f0, xf, a0, 0, 0, 0);
            a1 = __builtin_amdgcn_mfma_f32_16x16x32_bf16(f1, xf, a1, 0, 0, 0);
        }
        const int r = wid * 16 + l15;
#pragma unroll
        for (int q = 0; q < 4; ++q) lg[r * 20 + 4 * fq + q] = a0[q];
        if (fq == 0) {
#pragma unroll
            for (int q = 0; q < 4; ++q) lg[r * 20 + 16 + q] = a1[q];
        }
    }
    __syncthreads();
    int cls = 0, rank = 0; float wlo = 0.f, whi = 0.f;
    if (tid < 128) {
        const float rs = rowss[tid];
        float cl[4];
#pragma unroll
        for (int j = 0; j < 4; ++j) cl[j] = lg[tid * 20 + j] * rs + P.rc_b[j];
        int gi = 0; float mx = cl[0];
#pragma unroll
        for (int j = 1; j < 4; ++j) if (cl[j] > mx) { mx = cl[j]; gi = j; }
        float se = 0.f;
#pragma unroll
        for (int j = 0; j < 4; ++j) se += __expf(cl[j] - mx);
        const float pg = 1.0f / se;
        float f[4];
#pragma unroll
        for (int j = 0; j < 4; ++j) {
            float v = lg[tid * 20 + 4 + j] ;
            v = (gi == 1) ? lg[tid * 20 + 8 + j] : v; v = (gi == 2) ? lg[tid * 20 + 12 + j] : v; v = (gi == 3) ? lg[tid * 20 + 16 + j] : v;
            f[j] = v * rs + P.rf_b[gi * 4 + j];
        }
        int i0 = 0; float v0 = f[0];
#pragma unroll
        for (int j = 1; j < 4; ++j) if (f[j] > v0) { v0 = f[j]; i0 = j; }
        int i1 = -1; float v1 = 0.f;
#pragma unroll
        for (int j = 0; j < 4; ++j) if (j != i0 && (i1 < 0 || f[j] > v1)) { v1 = f[j]; i1 = j; }
        const float e1 = __expf(v1 - v0);
        const float wa = pg / (1.0f + e1), wb = pg * e1 / (1.0f + e1);
        const int lo = i0 < i1 ? i0 : i1, hi = i0 < i1 ? i1 : i0;
        wlo = (i0 < i1) ? wa : wb; whi = (i0 < i1) ? wb : wa;
        const int pidx = (lo == 0) ? (hi - 1) : ((lo == 1) ? (hi + 1) : 5);
        cls = gi * 6 + pidx;
        rank = __hip_atomic_fetch_add(&lcnt[cls], 1, __ATOMIC_RELAXED, __HIP_MEMORY_SCOPE_WORKGROUP);
    }
    __syncthreads();
    if (tid < 24) { const int n = lcnt[tid]; lcnt[24 + tid] = n ? (int)atomicAdd((unsigned*)P.ctl() + 64 + tid, (unsigned)n) : 0; }
    __syncthreads();
    if (tid < 128) {
        const int tok = c * 128 + tid;
        P.perm()[(size_t)cls * T_TOK + lcnt[24 + cls] + rank] = tok;
        P.tokw()[2 * tok] = wlo; P.tokw()[2 * tok + 1] = whi;
    }
}

#define C_ROWS 144
#define C_STAGE (C_ROWS * 128 + 32768)
#define C_MISC (3 * C_STAGE)
#define C_TOK_OFF (C_MISC)
#define C_RS_OFF (C_MISC + 576)
#define C_WL_OFF (C_MISC + 1152)
#define C_WH_OFF (C_MISC + 1728)
#define C_SS_OFF (C_MISC + 2304)
__device__ __forceinline__ void phaseC(const Params& P, LAS unsigned char* lds, int bid, int nblk, int tid_) {
    int tid = tid_;
    const int wid = __builtin_amdgcn_readfirstlane(tid >> 6), wr = wid >> 2, wc = wid & 3;
    const int rowbase = wr ? 80 : 0;
    LAS int* rowtok = (LAS int*)(lds + C_TOK_OFF);
    LAS float* rsv = (LAS float*)(lds + C_RS_OFF);
    LAS float* wlv = (LAS float*)(lds + C_WL_OFF);
    LAS float* whv = (LAS float*)(lds + C_WH_OFF);
    LAS float* sspart = (LAS float*)(lds + C_SS_OFF);
    const unsigned* gcnt = P.ctl() + 64;
    int total = 0;
    for (int k = 0; k < 24; ++k) total += ((int)gcnt[k] + C_ROWS - 1) / C_ROWS;
    for (int u = bid; u < total; u += nblk) {
        int cls = 0, j = u, cnt = 0;
        for (int k = 0; k < 24; ++k) { const int n = (int)gcnt[k], t = (n + C_ROWS - 1) / C_ROWS; if (j < t) { cls = k; cnt = n; break; } j -= t; }
        const int ntile = (cnt + C_ROWS - 1) / C_ROWS, rbeg = (int)(((long)cnt * j) / ntile), rend = (int)(((long)cnt * (j + 1)) / ntile), nvalid = rend - rbeg;
        __syncthreads();
        if (tid < C_ROWS) {
            const int r = tid < nvalid ? tid : nvalid - 1;
            const int tok = P.perm()[(size_t)cls * T_TOK + rbeg + r];
            rowtok[tid] = tok; rsv[tid] = P.rstd2()[tok]; wlv[tid] = P.tokw()[2 * tok]; whv[tid] = P.tokw()[2 * tok + 1];
        }
        __syncthreads();
        const int gi = cls / 6, pidx = cls - gi * 6;
        const int lo = pidx < 3 ? 0 : (pidx < 5 ? 1 : 2), hi = pidx < 3 ? pidx + 1 : (pidx < 5 ? pidx - 1 : 3);
        const int e_lo = gi * 4 + lo, e_hi = gi * 4 + hi;
        bf16_t* hid = P.hid() + (size_t)u * C_ROWS * 512;
        bf16_t* x2s = P.z() + (size_t)u * C_ROWS * DM;
        { asm volatile("" : "+v"(tid)); const int lane = tid & 63, fr = lane & 15, fq = lane >> 4;
#pragma unroll 1
        for (int s = 0; s < 2; ++s) {
            const int e = s ? e_hi : e_lo;
#pragma unroll 1
            for (int ch = 0; ch < 2; ++ch) {
                StagePtrs sp; sp.ksplit = 1 << 30; sp.bdelta = 0; sp.kt0 = 0; sp.nkt = 1 << 30;
#pragma unroll
                for (int q = 0; q < 3; ++q) { const int r = stage_row_a(wid, lane, q) < C_ROWS ? stage_row_a(wid, lane, q) : 0; sp.a[q] = (const char*)(P.x1b() + (size_t)rowtok[r] * DM) + stage_chunk_off(r, lane); }
#pragma unroll
                for (int q = 0; q < 4; ++q) { const int r = stage_row_b(wid, lane, q); sp.b[q] = (const char*)(P.wguT() + ((size_t)(e * 2 + ch) * 256 + r) * DM) + stage_chunk_off(r, lane); }
                f32x4 acc[5][4]; acc_zero<5>(acc);
                gemm_core<5>(lds, sp, DM / 64, acc, wid, wr, wc, lane, s == 0 && ch == 0);
#pragma unroll
                for (int m = 0; m < 5; ++m) if (m < 4 || wr == 0) {
                    const int r = rowbase + m * 16 + fr; const float rs = rsv[r], wsel = s ? whv[r] : wlv[r];
#pragma unroll
                    for (int n = 0; n < 2; ++n) {
                        float h[4];
#pragma unroll
                        for (int q = 0; q < 4; ++q) { const float g = acc[m][n][q] * rs, uu = acc[m][n + 2][q] * rs; h[q] = g / (1.0f + __expf(-g)) * uu * wsel; }
                        u32x2 w; w.x = cvt_pk_bf16(h[0], h[1]); w.y = cvt_pk_bf16(h[2], h[3]);
                        *(u32x2*)(hid + (size_t)r * 512 + 256 * s + 128 * ch + 32 * wc + 16 * n + 4 * fq) = w;
                    }
                    asm volatile("" ::: "memory");
                }
            }
        }
        }
        { asm volatile("" : "+v"(tid)); const int lane = tid & 63, fr = lane & 15, fq = lane >> 4;
        float ssr[5] = {0.f, 0.f, 0.f, 0.f, 0.f};
#pragma unroll 1
        for (int nt = 0; nt < 4; ++nt) {
            StagePtrs sp; sp.ksplit = 4; sp.bdelta = (long)(e_hi - e_lo) * DM * 256 * 2; sp.kt0 = 0; sp.nkt = 1 << 30;
#pragma unroll
            for (int q = 0; q < 3; ++q) { const int r = stage_row_a(wid, lane, q) < C_ROWS ? stage_row_a(wid, lane, q) : 0; sp.a[q] = (const char*)(hid + (size_t)r * 512) + stage_chunk_off(r, lane); }
#pragma unroll
            for (int q = 0; q < 4; ++q) { const int r = stage_row_b(wid, lane, q); sp.b[q] = (const char*)(P.wdT() + ((size_t)e_lo * DM + nt * 256 + r) * 256) + stage_chunk_off(r, lane); }
            f32x4 acc[5][4]; acc_zero<5>(acc);
            gemm_core<5>(lds, sp, 8, acc, wid, wr, wc, lane, nt == 0);
#pragma unroll
            for (int m = 0; m < 5; ++m) if (m < 4 || wr == 0) {
                const int r = rowbase + m * 16 + fr;
                if (r < nvalid) {
                    const bf16_t* xrow = P.x1b() + (size_t)rowtok[r] * DM + nt * 256 + wc * 64 + 4 * fq; bf16_t* srow = x2s + (size_t)r * DM + nt * 256 + wc * 64 + 4 * fq; float ss = 0.f;
                    u32x2 xwv[4];
#pragma unroll
                    for (int n = 0; n < 4; ++n) xwv[n] = *(const u32x2*)(xrow + n * 16);
                    asm volatile("s_waitcnt vmcnt(0)" ::: "memory");
#pragma unroll
                    for (int n = 0; n < 4; ++n) { const u32x2 xw = xwv[n]; f32x4 v = acc[m][n]; v[0] += bflo(xw.x); v[1] += bfhi(xw.x); v[2] += bflo(xw.y); v[3] += bfhi(xw.y);
                        u32x2 w; w.x = cvt_pk_bf16(v[0], v[1]); w.y = cvt_pk_bf16(v[2], v[3]); *(u32x2*)(srow + n * 16) = w; ss += v[0] * v[0] + v[1] * v[1] + v[2] * v[2] + v[3] * v[3]; }
                    ssr[m] += ss;
                }
                asm volatile("" ::: "memory");
            }
        }
#pragma unroll
        for (int m = 0; m < 5; ++m) if (m < 4 || wr == 0) {
            float ss = ssr[m]; ss += __shfl_xor(ss, 16); ss += __shfl_xor(ss, 32);
            if (fq == 0) sspart[(rowbase + m * 16 + fr) * 4 + wc] = ss;
        }
        }
        __syncthreads();
        { asm volatile("" : "+v"(tid)); const int lane = tid & 63, fr = lane & 15, fq = lane >> 4;
#pragma unroll 1
        for (int nt = 0; nt < 4; ++nt)
#pragma unroll
            for (int m = 0; m < 5; ++m) if (m < 4 || wr == 0) {
                const int r = rowbase + m * 16 + fr;
                if (r < nvalid) {
                    const float tsum = (sspart[r * 4] + sspart[r * 4 + 1]) + (sspart[r * 4 + 2] + sspart[r * 4 + 3]);
                    const float rs3 = rsqrtf(tsum * (1.0f / DM) + EPSV);
                    float* orow = P.out + (size_t)rowtok[r] * DM + nt * 256 + wc * 64 + 4 * fq; const bf16_t* srow = x2s + (size_t)r * DM + nt * 256 + wc * 64 + 4 * fq;
                    f32x4 gv[4]; u32x2 xwv[4];
#pragma unroll
                    for (int n = 0; n < 4; ++n) { gv[n] = *(const f32x4*)(P.norm_final + nt * 256 + wc * 64 + 4 * fq + n * 16); xwv[n] = *(const u32x2*)(srow + n * 16); }
                    asm volatile("s_waitcnt vmcnt(0)" ::: "memory");
#pragma unroll
                    for (int n = 0; n < 4; ++n) { const f32x4 g = gv[n]; const u32x2 xw = xwv[n];
                        f32x4 v; v[0] = bflo(xw.x) * rs3 * g[0]; v[1] = bfhi(xw.x) * rs3 * g[1]; v[2] = bflo(xw.y) * rs3 * g[2]; v[3] = bfhi(xw.y) * rs3 * g[3]; __builtin_nontemporal_store(v, (f32x4*)(orow + n * 16)); }
                }
                asm volatile("" ::: "memory");
            }
        }
    }
}


static void fill_params(Params& P, void* const* d_in, void* d_out, void* d_ws) {
    memset(&P, 0, sizeof(P));
    P.x = (const float*)d_in[0]; P.norm_mix = (const float*)d_in[1]; P.w_in = (const float*)d_in[2]; P.pool_w = (const float*)d_in[3]; P.pool_scale = (const float*)d_in[4];
    P.a_re = (const float*)d_in[5]; P.a_im = (const float*)d_in[6]; P.log_step = (const float*)d_in[7]; P.b_re = (const float*)d_in[8]; P.b_im = (const float*)d_in[9];
    P.c_re = (const float*)d_in[10]; P.c_im = (const float*)d_in[11]; P.ssm_d = (const float*)d_in[12]; P.glu_w = (const float*)d_in[13]; P.glu_b = (const float*)d_in[14];
    P.w_out = (const float*)d_in[15]; P.norm_ffn = (const float*)d_in[16]; P.rc_w = (const float*)d_in[17]; P.rc_b = (const float*)d_in[18]; P.rf_w = (const float*)d_in[19]; P.rf_b = (const float*)d_in[20];
    P.wg = (const float*)d_in[21]; P.wu = (const float*)d_in[22]; P.wd = (const float*)d_in[23]; P.norm_final = (const float*)d_in[24];
    P.out = (float*)d_out;
    P.ws = (char*)d_ws;
}
#define CTL_BYTES 65536

__global__ void __launch_bounds__(NTHR) mk_forward(Params P) {
    extern __shared__ __attribute__((aligned(16))) unsigned char lds_raw[];
    LAS unsigned char* lds = (LAS unsigned char*)lds_raw;
    const int bid = blockIdx.x, nblk = gridDim.x; int tid = threadIdx.x;
#define OPAQUE_TID() asm volatile("" : "+v"(tid))
    volatile LAS unsigned* xb_st = (volatile LAS unsigned*)(lds + LDS_BYTES - 16);
    if (tid < 4) xb_st[tid] = 0u;
    __syncthreads();
    const XcdBarrier xb = xcd_barrier_post(P.ctl(), xb_st);
    OPAQUE_TID();
    phase0_x(P, bid, nblk, tid);
    phase0_ssm(P, bid, nblk, tid);
    phase0_weights(P, bid, nblk, tid, (LAS float*)lds);
    xcd_barrier(xb);
    OPAQUE_TID();
    phaseA(P, lds, bid, nblk, tid);
    xcd_barrier(xb);
    OPAQUE_TID();
    phaseA2(P, bid, nblk, tid);
    xcd_barrier(xb);
    for (int c = bid; c < T_TOK / 128; c += nblk) {
        __syncthreads();
        OPAQUE_TID();
        phaseB_ssm(P, lds, c, tid);
        __syncthreads();
        OPAQUE_TID();
        phaseB_pool(P, c, tid);
        OPAQUE_TID();
        phaseB_glu(P, lds, c, tid);
        OPAQUE_TID();
        phaseB_wout(P, lds, c, tid);
        OPAQUE_TID();
        phaseB_router(P, lds, c, tid);
    }
    xcd_barrier(xb);
    OPAQUE_TID();
    phaseC(P, lds, bid, nblk, tid);
}

extern "C" void kernel_launch(void* const* d_in, const int* in_sizes, int n_in, void* d_out, int out_size, void* d_ws, size_t ws_size, hipStream_t stream) {
    static int grid_blocks = 0;
    if (!grid_blocks) {
        int dev = 0, cus = 0, per_cu = 0;
        (void)hipGetDevice(&dev);
        (void)hipDeviceGetAttribute(&cus, hipDeviceAttributeMultiprocessorCount, dev);
        (void)hipFuncSetAttribute((const void*)mk_forward, hipFuncAttributeMaxDynamicSharedMemorySize, LDS_BYTES);
        (void)hipOccupancyMaxActiveBlocksPerMultiprocessor(&per_cu, (const void*)mk_forward, NTHR, LDS_BYTES);
        if (per_cu < 1) per_cu = 1;
        grid_blocks = cus * per_cu; if (grid_blocks > 256) grid_blocks = 256;
    }
    Params P; fill_params(P, d_in, d_out, d_ws);
    (void)hipMemsetAsync(d_ws, 0, CTL_BYTES, stream);
    void* args[] = {&P};
    hipError_t e = hipLaunchCooperativeKernel((const void*)mk_forward, dim3(grid_blocks), dim3(NTHR), args, LDS_BYTES, stream);
    if (e != hipSuccess) fprintf(stderr, "cooperative launch failed: %s (grid %d)\n", hipGetErrorString(e), grid_blocks);
}
```

```cpp
#include <hip/hip_runtime.h>
#include <stdint.h>
#include <string.h>
#include <stdio.h>
#define T_TOK 32768
#define SEQ 8192
#define DM 1024
#define EPSV 1e-6f

#define LAS __attribute__((address_space(3)))
typedef unsigned short bf16_t;
typedef short bf16x8 __attribute__((ext_vector_type(8)));
typedef float f32x4 __attribute__((ext_vector_type(4)));
typedef float f32x16 __attribute__((ext_vector_type(16)));
typedef unsigned u32x2 __attribute__((ext_vector_type(2)));
typedef unsigned u32x4 __attribute__((ext_vector_type(4)));

#define NTHR 512
#define LDS_BYTES 163840
#define STAGE_B 49152
#define MISC_OFF (3 * STAGE_B)

__device__ __forceinline__ unsigned cvt_pk_bf16(float lo, float hi) { unsigned r; asm("v_cvt_pk_bf16_f32 %0, %1, %2" : "=v"(r) : "v"(lo), "v"(hi)); return r; }
__device__ __forceinline__ bf16_t f2bf(float f) { return (bf16_t)(cvt_pk_bf16(f, 0.f) & 0xffffu); }
__device__ __forceinline__ float bf2f(bf16_t h) { return __uint_as_float(((unsigned)h) << 16); }
__device__ __forceinline__ float bflo(unsigned w) { return __uint_as_float(w << 16); }
__device__ __forceinline__ float bfhi(unsigned w) { return __uint_as_float(w & 0xffff0000u); }

#define VM_WAIT0() do { asm volatile("" ::: "memory"); __builtin_amdgcn_s_waitcnt(0x0F70); asm volatile("" ::: "memory"); } while (0)

struct StagePtrs { const char* a[3]; const char* b[4]; long bdelta; int ksplit; int kt0; int nkt; };

__device__ __forceinline__ int stage_row_a(int wid, int lane, int i) { return (i < 2 ? (wid * 2 + i) * 8 : 128 + wid * 8) + (lane >> 3); }
__device__ __forceinline__ int stage_row_b(int wid, int lane, int i) { return (wid * 4 + i) * 8 + (lane >> 3); }
__device__ __forceinline__ int stage_chunk_off(int row, int lane) { return (((lane & 7) ^ ((row >> 1) & 7)) << 4); }

template <int MF0>
__device__ __forceinline__ void stage_issue(LAS unsigned char* lds, int s, const StagePtrs& sp, int kt_, int wid) {
    constexpr int ABYTES = (64 + 16 * MF0) * 128, SB = ABYTES + 32768;
    LAS unsigned char* base = lds + s * SB;
    int kt = kt_ + sp.kt0; kt = (kt >= sp.nkt) ? kt - sp.nkt : kt;
#pragma unroll
    for (int i = 0; i < 2; ++i) __builtin_amdgcn_global_load_lds((const unsigned*)(sp.a[i] + (size_t)kt * 128), (LAS unsigned*)(base + (wid * 2 + i) * 1024), 16, 0, 0);
    if (MF0 == 5 && wid < 2) __builtin_amdgcn_global_load_lds((const unsigned*)(sp.a[2] + (size_t)kt * 128), (LAS unsigned*)(base + (16 + wid) * 1024), 16, 0, 0);
    const long bofs = (kt < sp.ksplit) ? (long)kt * 128 : (long)(kt - sp.ksplit) * 128 + sp.bdelta;
#pragma unroll
    for (int i = 0; i < 4; ++i) __builtin_amdgcn_global_load_lds((const unsigned*)(sp.b[i] + bofs), (LAS unsigned*)(base + ABYTES + (wid * 4 + i) * 1024), 16, 0, 0);
}

struct NoPre { __device__ __forceinline__ void operator()() const {} };
#define GC_BAR() do { asm volatile("s_waitcnt lgkmcnt(0)" ::: "memory"); __builtin_amdgcn_s_barrier(); asm volatile("" ::: "memory"); } while (0)
#define GC_WAIT1() do { if (extra) asm volatile("s_waitcnt vmcnt(7)" ::: "memory"); else asm volatile("s_waitcnt vmcnt(6)" ::: "memory"); } while (0)
template <int MF0, int MODE, int NPRE, int NPRE1, class Pre>
__device__ __forceinline__ void gemm_ktile(LAS unsigned char* lds, const StagePtrs& sp, int nkt, int kt, int s, f32x4 (&acc)[MF0][4], int wid, int wr, int aoff, int boff, int offk0, int offk1, bool extra, Pre& pre) {
    constexpr int ABYTES = (64 + 16 * MF0) * 128, SB = ABYTES + 32768;
    if (MODE == 0) { if (kt + 2 < nkt) { const int s2 = (s >= 1) ? s - 1 : 2; stage_issue<MF0>(lds, s2, sp, kt + 2, wid); } }
    const LAS unsigned char* st = lds + s * SB;
    bf16x8 af[2][MF0], bfr[2][4];
#pragma unroll
    for (int ks = 0; ks < 2; ++ks) {
        const int ok = ks ? offk1 : offk0;
#pragma unroll
        for (int m = 0; m < MF0; ++m) if (m < 4 || wr == 0) af[ks][m] = *(const LAS bf16x8*)(st + aoff + m * 2048 + ok);
#pragma unroll
        for (int n = 0; n < 4; ++n) bfr[ks][n] = *(const LAS bf16x8*)(st + boff + n * 2048 + ok);
    }
    if (MODE == 0) { if (kt + 2 < nkt) GC_WAIT1(); else asm volatile("s_waitcnt vmcnt(0)" ::: "memory"); }
    if (MODE == 1) { pre(); if (NPRE1 != NPRE && wr == 1) asm volatile("s_waitcnt vmcnt(%0)" :: "n"(NPRE1) : "memory"); else asm volatile("s_waitcnt vmcnt(%0)" :: "n"(NPRE) : "memory"); }
    GC_BAR();
    __builtin_amdgcn_s_setprio(1);
#pragma unroll
    for (int ks = 0; ks < 2; ++ks)
#pragma unroll
        for (int m = 0; m < MF0; ++m) if (m < 4 || wr == 0) {
#pragma unroll
            for (int n = 0; n < 4; ++n) acc[m][n] = __builtin_amdgcn_mfma_f32_16x16x32_bf16(bfr[ks][n], af[ks][m], acc[m][n], 0, 0, 0); }
    __builtin_amdgcn_s_setprio(0);
    GC_BAR();
}
template <int MF0, int NPRE = 0, class Pre = NoPre, int NPRE1 = NPRE>
__device__ __forceinline__ void gemm_core(LAS unsigned char* lds, const StagePtrs& sp, int nkt, f32x4 (&acc)[MF0][4], int wid, int wr, int wc, int lane, bool drain = true, Pre pre = Pre()) {
    constexpr int ABYTES = (64 + 16 * MF0) * 128;
    const int fr = lane & 15, fq = lane >> 4, sw = fr >> 1;
    const int offk0 = fr * 128 + ((fq ^ sw) << 4), offk1 = fr * 128 + (((4 + fq) ^ sw) << 4);
    const int aoff = wr * (MF0 * 2048), boff = ABYTES + wc * 8192;
    const bool extra = (MF0 == 5) && (wid < 2);
    if (drain) asm volatile("s_waitcnt vmcnt(0)" ::: "memory");
    GC_BAR();
    stage_issue<MF0>(lds, 0, sp, 0, wid);
    if (nkt > 1) stage_issue<MF0>(lds, 1, sp, 1, wid);
    if (nkt > 1 && drain) GC_WAIT1(); else asm volatile("s_waitcnt vmcnt(0)" ::: "memory");
    GC_BAR();
    if (wr == 1) GC_BAR();
    int s = 0;
    const int nloop = NPRE > 0 ? nkt - 2 : nkt;
#pragma unroll 1
    for (int kt = 0; kt < nloop; ++kt) {
        gemm_ktile<MF0, 0, NPRE, NPRE1, Pre>(lds, sp, nkt, kt, s, acc, wid, wr, aoff, boff, offk0, offk1, extra, pre);
        s = (s == 2) ? 0 : s + 1;
    }
    if (NPRE > 0) {
        gemm_ktile<MF0, 1, NPRE, NPRE1, Pre>(lds, sp, nkt, nkt - 2, s, acc, wid, wr, aoff, boff, offk0, offk1, extra, pre);
        s = (s == 2) ? 0 : s + 1;
        gemm_ktile<MF0, 2, NPRE, NPRE1, Pre>(lds, sp, nkt, nkt - 1, s, acc, wid, wr, aoff, boff, offk0, offk1, extra, pre);
    }
    if (wr == 0) GC_BAR();
}
#undef GC_BAR
#undef GC_WAIT1
template <int MF0>
__device__ __forceinline__ void acc_zero(f32x4 (&acc)[MF0][4]) {
#pragma unroll
    for (int m = 0; m < MF0; ++m)
#pragma unroll
        for (int n = 0; n < 4; ++n) acc[m][n] = (f32x4){0.f, 0.f, 0.f, 0.f};
}


#define XB_TMO      128
#define XB_XCNT(j)  (256  + 64 * (j))
#define XB_XSUB(j)  (1280 + 64 * (j))
#define XB_XGEN(j)  (2304 + 64 * (j))
#define XB_TOP      3328
#define XB_TOPGEN   3392
#define XCD_BAR_WORDS 3456
#define XB_SPIN_CAP (1u << 18)

__device__ __forceinline__ unsigned xb_ld(unsigned* p)              { return __hip_atomic_load(p, __ATOMIC_RELAXED, __HIP_MEMORY_SCOPE_AGENT); }
__device__ __forceinline__ unsigned xb_add(unsigned* p, unsigned v) { return __hip_atomic_fetch_add(p, v, __ATOMIC_RELAXED, __HIP_MEMORY_SCOPE_AGENT); }
__device__ __forceinline__ unsigned xb_xcc_id() { return (unsigned)__builtin_amdgcn_s_getreg((3 << 11) | 20) & 0xFu; }
#define XB_SPIN(cond, bar) do { unsigned _sp = 0; while (cond) { __builtin_amdgcn_s_sleep(1); \
    if ((++_sp & 255u) == 0u) { if (xb_ld(&(bar)[XB_TMO])) break; if (_sp > XB_SPIN_CAP) { atomicAdd(&(bar)[XB_TMO], 1u); break; } } } } while (0)

struct XcdBarrier {
    unsigned* bar; unsigned x;
    volatile LAS unsigned* st;
};

__device__ __forceinline__ XcdBarrier xcd_barrier_post(unsigned* bar, volatile LAS unsigned* st) {
    XcdBarrier b; b.bar = bar; b.x = xb_xcc_id(); b.st = st;
    if (threadIdx.x == 0) (void)xb_add(&bar[XB_XCNT(b.x)], 1u);
    return b;
}
__device__ __forceinline__ void xcd_barrier_complete(unsigned* bar, unsigned x, unsigned& nloc, unsigned& nx) {
    const unsigned G = gridDim.x * gridDim.y * gridDim.z;
    unsigned sum, cnt, mine, sp = 0u;
    for (;;) {
        sum = 0u; cnt = 0u; mine = 0u;
#pragma unroll
        for (unsigned j = 0; j < 16; ++j) { const unsigned c = xb_ld(&bar[XB_XCNT(j)]); sum += c; cnt += (c > 0u) ? 1u : 0u; mine = (j == x) ? c : mine; }
        if (sum == G) break;
        __builtin_amdgcn_s_sleep(1);
        if ((++sp & 255u) == 0u) { if (xb_ld(&bar[XB_TMO])) break; if (sp > XB_SPIN_CAP) { atomicAdd(&bar[XB_TMO], 1u); break; } }
    }
    nloc = mine > 0u ? mine : 1u; nx = cnt > 0u ? cnt : 1u;
}

__device__ __forceinline__ void xcd_barrier(const XcdBarrier& b) {
    asm volatile("s_waitcnt vmcnt(0)" ::: "memory");
    __syncthreads();
    if (threadIdx.x == 0) {
        unsigned* bar = b.bar;
        __builtin_amdgcn_s_waitcnt(0);
        unsigned nloc = b.st[0], nx = b.st[1];
        if (nloc == 0u) { xcd_barrier_complete(bar, b.x, nloc, nx); b.st[0] = nloc; b.st[1] = nx; }
        const unsigned old = xb_add(&bar[XB_XSUB(b.x)], 1u);
        const unsigned gen = old / nloc;
        if (old + 1u == (gen + 1u) * nloc) {
            __builtin_amdgcn_fence(__ATOMIC_RELEASE, "agent");
            asm volatile("s_waitcnt vmcnt(0)" ::: "memory");
            const unsigned og = xb_add(&bar[XB_TOP], 1u);
            const unsigned tg = og / nx;
            if (og + 1u == (tg + 1u) * nx) xb_add(&bar[XB_TOPGEN], 1u);
            else XB_SPIN(xb_ld(&bar[XB_TOPGEN]) == tg, bar);
            __builtin_amdgcn_fence(__ATOMIC_ACQUIRE, "agent");
            xb_add(&bar[XB_XGEN(b.x)], 1u);
            asm volatile("s_waitcnt vmcnt(0)" ::: "memory");
        } else {
            XB_SPIN(xb_ld(&bar[XB_XGEN(b.x)]) == gen, bar);
            __builtin_amdgcn_fence(__ATOMIC_ACQUIRE, "agent");
            asm volatile("s_waitcnt vmcnt(0)" ::: "memory");
        }
    }
    __syncthreads();
}


struct Params {
    const float* x; const float* norm_mix; const float* w_in; const float* pool_w; const float* pool_scale;
    const float* a_re; const float* a_im; const float* log_step; const float* b_re; const float* b_im; const float* c_re; const float* c_im; const float* ssm_d;
    const float* glu_w; const float* glu_b; const float* w_out; const float* norm_ffn; const float* rc_w; const float* rc_b; const float* rf_w; const float* rf_b;
    const float* wg; const float* wu; const float* wd; const float* norm_final;
    float* out;
    char* ws;
#define WS_MB(x) ((size_t)(x) << 20)
    __device__ __forceinline__ unsigned* ctl() const { return (unsigned*)ws; }
    __device__ __forceinline__ float* rstd1() const { return (float*)(ws + WS_MB(1)); }
    __device__ __forceinline__ float* rstd2() const { return (float*)(ws + WS_MB(1) + 131072); }
    __device__ __forceinline__ float* tokw() const { return (float*)(ws + WS_MB(1) + 262144); }
    __device__ __forceinline__ float* abar() const { return (float*)(ws + WS_MB(2)); }
    __device__ __forceinline__ float* a64() const { return (float*)(ws + WS_MB(2) + 16384); }
    __device__ __forceinline__ float* a128() const { return (float*)(ws + WS_MB(2) + 32768); }
    __device__ __forceinline__ bf16_t* bbT() const { return (bf16_t*)(ws + WS_MB(2) + 65536); }
    __device__ __forceinline__ bf16_t* cmT() const { return (bf16_t*)(ws + WS_MB(2) + 65536 + 131072); }
    __device__ __forceinline__ bf16_t* wrT() const { return (bf16_t*)(ws + WS_MB(3)); }
    __device__ __forceinline__ float* send0() const { return (float*)(ws + WS_MB(4)); }
    __device__ __forceinline__ float* send128() const { return (float*)(ws + WS_MB(8)); }
    __device__ __forceinline__ int* perm() const { return (int*)(ws + WS_MB(12)); }
    __device__ __forceinline__ bf16_t* w_inT() const { return (bf16_t*)(ws + WS_MB(16)); }
    __device__ __forceinline__ bf16_t* gluT() const { return (bf16_t*)(ws + WS_MB(18)); }
    __device__ __forceinline__ bf16_t* w_outT() const { return (bf16_t*)(ws + WS_MB(19)); }
    __device__ __forceinline__ bf16_t* wguT() const { return (bf16_t*)(ws + WS_MB(24)); }
    __device__ __forceinline__ bf16_t* wdT() const { return (bf16_t*)(ws + WS_MB(40)); }
    __device__ __forceinline__ bf16_t* hid() const { return (bf16_t*)(ws + WS_MB(48)); }
    __device__ __forceinline__ bf16_t* xb() const { return (bf16_t*)(ws + WS_MB(96)); }
    __device__ __forceinline__ bf16_t* z() const { return (bf16_t*)(ws + WS_MB(160)); }
    __device__ __forceinline__ bf16_t* ycat() const { return (bf16_t*)(ws + WS_MB(224)); }
    __device__ __forceinline__ bf16_t* x1b() const { return (bf16_t*)(ws + WS_MB(288)); }
    __device__ __forceinline__ bf16_t* ybuf() const { return (bf16_t*)(ws + WS_MB(352)); }
};

__device__ __forceinline__ void phase0_x(const Params& P, int bid, int nblk, int tid) {
    const int wave = tid >> 6, lane = tid & 63;
    for (int row = (bid * 8 + wave) * 4; row < T_TOK; row += nblk * 32) {
        f32x4 v[4][4];
#pragma unroll
        for (int r = 0; r < 4; ++r)
#pragma unroll
            for (int i = 0; i < 4; ++i) v[r][i] = __builtin_nontemporal_load((const f32x4*)(P.x + (size_t)(row + r) * DM + i * 256 + lane * 4));
        VM_WAIT0();
#pragma unroll
        for (int r = 0; r < 4; ++r) {
            float s = 0.f;
#pragma unroll
            for (int i = 0; i < 4; ++i) s += v[r][i][0] * v[r][i][0] + v[r][i][1] * v[r][i][1] + v[r][i][2] * v[r][i][2] + v[r][i][3] * v[r][i][3];
#pragma unroll
            for (int o = 32; o > 0; o >>= 1) s += __shfl_xor(s, o);
            if (lane == 0) P.rstd1()[row + r] = rsqrtf(s * (1.0f / DM) + EPSV);
            bf16_t* xo = P.xb() + (size_t)(row + r) * DM;
#pragma unroll
            for (int i = 0; i < 4; ++i) { u32x2 w; w.x = cvt_pk_bf16(v[r][i][0], v[r][i][1]); w.y = cvt_pk_bf16(v[r][i][2], v[r][i][3]); *(u32x2*)(xo + i * 256 + lane * 4) = w; }
        }
    }
}

struct TrJob { const float* sa; const float* sb; const float* scale; bf16_t* dst; int lds; int ldd; };
__device__ __forceinline__ void tr_describe(const Params& P, int job, TrJob& J) {
    if (job < 128) { const int n0 = 512 + (job >> 4) * 64, k0 = (job & 15) * 64;
        J.sa = P.w_in + (size_t)k0 * DM + n0; J.sb = J.sa + 32; J.scale = P.norm_mix + k0; J.dst = P.w_inT() + (size_t)n0 * DM + k0; J.lds = DM; J.ldd = DM; }
    else if (job < 192) { const int j = job - 128, n0 = (j >> 3) * 64, k0 = (j & 7) * 64;
        J.sa = P.glu_w + (size_t)k0 * 512 + n0; J.sb = J.sa + 32; J.scale = nullptr; J.dst = P.gluT() + (size_t)n0 * 512 + k0; J.lds = 512; J.ldd = 512; }
    else if (job < 448) { const int j = job - 192, n0 = (j >> 4) * 64, k0 = (j & 15) * 64;
        J.sa = P.w_out + (size_t)k0 * DM + n0; J.sb = J.sa + 32; J.scale = nullptr; J.dst = P.w_outT() + (size_t)n0 * DM + k0; J.lds = DM; J.ldd = DM; }
    else if (job < 2496) { const int j = job - 448, kt = j & 15, wc = (j >> 4) & 3, ch = (j >> 6) & 1, e = j >> 7, k0 = kt * 64, f0 = 128 * ch + 32 * wc;
        J.sa = P.wg + ((size_t)e * DM + k0) * 256 + f0; J.sb = P.wu + ((size_t)e * DM + k0) * 256 + f0; J.scale = P.norm_ffn + k0;
        J.dst = P.wguT() + ((size_t)((e * 2 + ch) * 256 + wc * 64)) * DM + k0; J.lds = 256; J.ldd = DM; }
    else { const int j = job - 2496, ft = j & 3, nt = (j >> 2) & 15, e = j >> 6, f0 = ft * 64, n0 = nt * 64;
        J.sa = P.wd + ((size_t)e * 256 + f0) * DM + n0; J.sb = J.sa + 32; J.scale = nullptr; J.dst = P.wdT() + ((size_t)e * DM + n0) * 256 + f0; J.lds = DM; J.ldd = 256; }
}
__device__ __forceinline__ void tr_round(const Params& P, int job0, int jstep, int njobs_end, LAS float* tl, int tid) {
    TrJob J[4]; f32x4 a[4], b[4]; float sc[4];
    const int k = tid >> 3, c8 = (tid & 7) * 8;
#pragma unroll
    for (int q = 0; q < 4; ++q) { const int job = job0 + q * jstep; if (job < njobs_end) { tr_describe(P, job, J[q]);
        const float* src = (c8 < 32 ? J[q].sa + c8 : J[q].sb + (c8 - 32)) + (size_t)k * J[q].lds;
        a[q] = __builtin_nontemporal_load((const f32x4*)src); b[q] = __builtin_nontemporal_load((const f32x4*)(src + 4));
        sc[q] = J[q].scale ? J[q].scale[k] : 1.0f; } }
    VM_WAIT0();
#pragma unroll
    for (int q = 0; q < 4; ++q) if (job0 + q * jstep < njobs_end) { LAS float* t = tl + q * (64 * 65) + k * 65 + c8;
        t[0] = a[q][0] * sc[q]; t[1] = a[q][1] * sc[q]; t[2] = a[q][2] * sc[q]; t[3] = a[q][3] * sc[q]; t[4] = b[q][0] * sc[q]; t[5] = b[q][1] * sc[q]; t[6] = b[q][2] * sc[q]; t[7] = b[q][3] * sc[q]; }
    __syncthreads();
    const int n = tid >> 3, k8 = (tid & 7) * 8;
#pragma unroll
    for (int q = 0; q < 4; ++q) if (job0 + q * jstep < njobs_end) { const LAS float* t = tl + q * (64 * 65);
        u32x4 w;
        w.x = cvt_pk_bf16(t[(k8 + 0) * 65 + n], t[(k8 + 1) * 65 + n]); w.y = cvt_pk_bf16(t[(k8 + 2) * 65 + n], t[(k8 + 3) * 65 + n]);
        w.z = cvt_pk_bf16(t[(k8 + 4) * 65 + n], t[(k8 + 5) * 65 + n]); w.w = cvt_pk_bf16(t[(k8 + 6) * 65 + n], t[(k8 + 7) * 65 + n]);
        *(u32x4*)(J[q].dst + (size_t)n * J[q].ldd + k8) = w; }
    __syncthreads();
}

#define N_TR_JOBS 3648
__device__ __forceinline__ void phase0_weights(const Params& P, int bid, int nblk, int tid, LAS float* tl) {
    for (int job = bid; job < 3520; job += 4 * nblk) tr_round(P, job, nblk, 3520, tl, tid);
    for (int job = 3520 + bid; job < N_TR_JOBS; job += nblk) {
        {
            const int j = job - 3520, n0 = (j >> 4) * 64, k0 = (j & 15) * 64, g = n0 >> 7, d0 = n0 & 127;
            LAS float* wa = tl + 64 * 65;
            LAS float* pb = wa + 64 * 129;
            for (int i = tid; i < 64 * 32; i += NTHR) { const int k = i >> 5, c4 = (i & 31) * 4; const f32x4 v = *(const f32x4*)(P.w_in + (size_t)(k0 + k) * DM + 128 * g + c4);
                LAS float* t = wa + k * 129 + c4; t[0] = v[0]; t[1] = v[1]; t[2] = v[2]; t[3] = v[3]; }
            for (int i = tid; i < 128 * 16; i += NTHR) { const int cc = i >> 4, d4 = (i & 15) * 4; const f32x4 v = *(const f32x4*)(P.pool_w + ((size_t)g * 128 + cc) * 128 + d0 + d4);
                LAS float* t = pb + cc * 65 + d4; t[0] = v[0]; t[1] = v[1]; t[2] = v[2]; t[3] = v[3]; }
            __syncthreads();
            {
                const int k = tid >> 3, dl = tid & 7; float a[8];
#pragma unroll
                for (int q = 0; q < 8; ++q) a[q] = 0.f;
                for (int cc = 0; cc < 128; ++cc) { const float wv = wa[k * 129 + cc];
#pragma unroll
                    for (int q = 0; q < 8; ++q) a[q] += wv * pb[cc * 65 + dl + 8 * q]; }
                const float nm = P.norm_mix[k0 + k];
#pragma unroll
                for (int q = 0; q < 8; ++q) tl[k * 65 + dl + 8 * q] = a[q] * nm * P.pool_scale[n0 + dl + 8 * q];
            }
            __syncthreads();
            { const int n = tid >> 3, k8 = (tid & 7) * 8; u32x4 w;
              w.x = cvt_pk_bf16(tl[(k8 + 0) * 65 + n], tl[(k8 + 1) * 65 + n]); w.y = cvt_pk_bf16(tl[(k8 + 2) * 65 + n], tl[(k8 + 3) * 65 + n]);
              w.z = cvt_pk_bf16(tl[(k8 + 4) * 65 + n], tl[(k8 + 5) * 65 + n]); w.w = cvt_pk_bf16(tl[(k8 + 6) * 65 + n], tl[(k8 + 7) * 65 + n]);
              *(u32x4*)(P.w_inT() + (size_t)(n0 + n) * DM + k0 + k8) = w; }
            __syncthreads();
        }
    }
    for (int i = bid * NTHR + tid; i < 32 * DM; i += nblk * NTHR) {
        const int j = i >> 10, k = i & 1023; float v = 0.f;
        if (j < 4) v = P.norm_ffn[k] * P.rc_w[k * 4 + j]; else if (j < 20) v = P.norm_ffn[k] * P.rf_w[k * 16 + j - 4];
        P.wrT()[i] = f2bf(v);
    }
}

__device__ __forceinline__ void phaseA(const Params& P, LAS unsigned char* lds, int bid, int nblk, int tid) {
    const int wid = __builtin_amdgcn_readfirstlane(tid >> 6), lane = tid & 63, wr = wid >> 2, wc = wid & 3, fr = lane & 15, fq = lane >> 4;
    for (int u = bid; u < 1024; u += nblk) {
        const int i = u / nblk, b = u % nblk;
        int mt, nt;
        if (nblk == 256) { const int xcd = b & 7, idx = b >> 3; mt = (i * 8 + xcd) * 8 + (idx >> 2); nt = idx & 3; } else { mt = u >> 2; nt = u & 3; }
        StagePtrs sp; sp.a[2] = nullptr; sp.ksplit = 1 << 30; sp.bdelta = 0; sp.kt0 = 0; sp.nkt = 1 << 30;
#pragma unroll
        for (int j = 0; j < 2; ++j) { const int r = stage_row_a(wid, lane, j); sp.a[j] = (const char*)(P.xb() + (size_t)(mt * 128 + r) * DM) + stage_chunk_off(r, lane); }
#pragma unroll
        for (int j = 0; j < 4; ++j) { const int r = stage_row_b(wid, lane, j); sp.b[j] = (const char*)(P.w_inT() + (size_t)(nt * 256 + r) * DM) + stage_chunk_off(r, lane); }
        f32x4 acc[4][4]; acc_zero<4>(acc);
        gemm_core<4>(lds, sp, DM / 64, acc, wid, wr, wc, lane, false);
        float rsm[4];
#pragma unroll
        for (int m = 0; m < 4; ++m) rsm[m] = P.rstd1()[mt * 128 + wr * 64 + m * 16 + fr];
        VM_WAIT0();
#pragma unroll
        for (int m = 0; m < 4; ++m) {
            const int row = mt * 128 + wr * 64 + m * 16 + fr; const float rs = rsm[m];
            bf16_t* zr = P.z() + (size_t)row * DM + nt * 256 + wc * 64 + 4 * fq;
#pragma unroll
            for (int n = 0; n < 4; ++n) { u32x2 w; w.x = cvt_pk_bf16(acc[m][n][0] * rs, acc[m][n][1] * rs); w.y = cvt_pk_bf16(acc[m][n][2] * rs, acc[m][n][3] * rs); *(u32x2*)(zr + n * 16) = w; }
        }
    }
}


__device__ __forceinline__ void phase0_ssm(const Params& P, int bid, int nblk, int tid) {
    for (int i = bid * NTHR + tid; i < 2048; i += nblk * NTHR) {
        const int g = i >> 6;
        const double lr = (double)P.a_re[i], li = (double)P.a_im[i], step = exp((double)P.log_step[g]);
        const double mag = exp(lr * step), ar = mag * cos(li * step), ai = mag * sin(li * step);
        const double den = lr * lr + li * li, nr = ar - 1.0, ni = ai;
        const double qr = (nr * lr + ni * li) / den, qi = (ni * lr - nr * li) / den;
        P.abar()[2 * i] = (float)ar; P.abar()[2 * i + 1] = (float)ai;
        const double m64 = exp(64.0 * lr * step), m128 = exp(128.0 * lr * step);
        P.a64()[2 * i] = (float)(m64 * cos(64.0 * li * step)); P.a64()[2 * i + 1] = (float)(m64 * sin(64.0 * li * step));
        P.a128()[2 * i] = (float)(m128 * cos(128.0 * li * step)); P.a128()[2 * i + 1] = (float)(m128 * sin(128.0 * li * step));
        const int p = i & 63;
        float brv[16], biv[16];
#pragma unroll
        for (int h = 0; h < 16; ++h) { brv[h] = P.b_re[i * 16 + h]; biv[h] = P.b_im[i * 16 + h]; }
        VM_WAIT0();
#pragma unroll
        for (int h = 0; h < 16; ++h) {
            const double br = (double)brv[h], bi = (double)biv[h];
            P.bbT()[((size_t)g * 128 + p) * 16 + h] = f2bf((float)(qr * br - qi * bi));
            P.bbT()[((size_t)g * 128 + 64 + p) * 16 + h] = f2bf((float)(qr * bi + qi * br));
        }
    }
    for (int i = bid * NTHR + tid; i < 32 * 16 * 160; i += nblk * NTHR) {
        const int k = i % 160, gh = i / 160, h = gh & 15;
        float v = 0.f;
        if (k < 128) v = (k & 1) ? -P.c_im[gh * 64 + (k >> 1)] : P.c_re[gh * 64 + (k >> 1)];
        else if (k - 128 == h) v = P.ssm_d[gh];
        P.cmT()[i] = f2bf(v);
    }
}

struct SsmGroup { bf16x8 bop[4]; float ar[2], ai[2]; };
__device__ __forceinline__ void ssm_load_group(const Params& P, int g, int lane, SsmGroup& G) {
#pragma unroll
    for (int cb = 0; cb < 4; ++cb) G.bop[cb] = *(const bf16x8*)(P.bbT() + ((size_t)g * 128 + 32 * cb + (lane & 31)) * 16 + 8 * (lane >> 5));
#pragma unroll
    for (int sp = 0; sp < 2; ++sp) { const int s = g * 64 + 32 * sp + (lane & 31); G.ar[sp] = P.abar()[2 * s]; G.ai[sp] = P.abar()[2 * s + 1]; }
}
__device__ __forceinline__ int ssm_row_token(int lane, int j) { const int r = lane & 31; return 64 * ((r >> 2) & 1) + 16 * j + (r & 3) + 4 * (r >> 3); }

__device__ __forceinline__ void phaseA2(const Params& P, int bid, int nblk, int tid) {
    const int wid = tid >> 6, lane = tid & 63;
    for (int c = bid; c < 256; c += nblk) {
        for (int gi = 0; gi < 4; ++gi) {
            const int g = wid * 4 + gi;
            SsmGroup G; ssm_load_group(P, g, lane, G);
            float xr[2] = {0.f, 0.f}, xi[2] = {0.f, 0.f};
#pragma unroll 1
            for (int j = 0; j < 4; ++j) {
                const int tok = c * 128 + ssm_row_token(lane, j);
                const bf16x8 aop = *(const bf16x8*)(P.z() + (size_t)tok * DM + 512 + 16 * g + 8 * (lane >> 5));
                f32x16 bu[4];
#pragma unroll
                for (int cb = 0; cb < 4; ++cb) { f32x16 zz; for (int q = 0; q < 16; ++q) zz[q] = 0.f; bu[cb] = __builtin_amdgcn_mfma_f32_32x32x16_bf16(aop, G.bop[cb], zz, 0, 0, 0); }
#pragma unroll
                for (int i = 0; i < 16; ++i)
#pragma unroll
                    for (int sp = 0; sp < 2; ++sp) {
                        const float nxr = G.ar[sp] * xr[sp] - G.ai[sp] * xi[sp] + bu[sp][i];
                        const float nxi = G.ar[sp] * xi[sp] + G.ai[sp] * xr[sp] + bu[2 + sp][i];
                        xr[sp] = nxr; xi[sp] = nxi;
                    }
            }
#pragma unroll
            for (int sp = 0; sp < 2; ++sp) {
                const float s1r = __shfl(xr[sp], (lane & 31) + 32), s1i = __shfl(xi[sp], (lane & 31) + 32);
                if (lane < 32) {
                    const int s = g * 64 + 32 * sp + lane;
                    const float pr = P.a64()[2 * s], pi = P.a64()[2 * s + 1];
                    VM_WAIT0();
                    const size_t o = ((size_t)c * 2048 + s) * 2;
                    P.send0()[o] = xr[sp]; P.send0()[o + 1] = xi[sp];
                    P.send128()[o] = pr * xr[sp] - pi * xi[sp] + s1r; P.send128()[o + 1] = pr * xi[sp] + pi * xr[sp] + s1i;
                }
            }
        }
    }
}

#define XA_STRIDE 336
__device__ __forceinline__ float gelu_tanh(float y) { const float a = 1.5957691216057308f * (y + 0.044715f * y * y * y); return y / (1.0f + __expf(-a)); }

__device__ __forceinline__ void phaseB_ssm(const Params& P, LAS unsigned char* lds, int c, int tid) {
    const int wid = tid >> 6, lane = tid & 63;
    LAS float* carry = (LAS float*)(lds + 86016);
    {
        const int c0 = c & ~63;
        f32x4 cr0 = {0.f, 0.f, 0.f, 0.f}, cr1 = {0.f, 0.f, 0.f, 0.f};
        const f32x4 p0 = *(const f32x4*)(P.a128() + 8 * tid), p1 = *(const f32x4*)(P.a128() + 8 * tid + 4);
        int cc = c0;
        for (; cc + 8 <= c; cc += 8) {
            f32x4 s0[8], s1[8];
#pragma unroll
            for (int q = 0; q < 8; ++q) { s0[q] = *(const f32x4*)(P.send128() + (size_t)(cc + q) * 4096 + 8 * tid); s1[q] = *(const f32x4*)(P.send128() + (size_t)(cc + q) * 4096 + 8 * tid + 4); }
#pragma unroll
            for (int q = 0; q < 8; ++q) {
                f32x4 n0, n1;
                n0[0] = p0[0] * cr0[0] - p0[1] * cr0[1] + s0[q][0]; n0[1] = p0[0] * cr0[1] + p0[1] * cr0[0] + s0[q][1];
                n0[2] = p0[2] * cr0[2] - p0[3] * cr0[3] + s0[q][2]; n0[3] = p0[2] * cr0[3] + p0[3] * cr0[2] + s0[q][3];
                n1[0] = p1[0] * cr1[0] - p1[1] * cr1[1] + s1[q][0]; n1[1] = p1[0] * cr1[1] + p1[1] * cr1[0] + s1[q][1];
                n1[2] = p1[2] * cr1[2] - p1[3] * cr1[3] + s1[q][2]; n1[3] = p1[2] * cr1[3] + p1[3] * cr1[2] + s1[q][3];
                cr0 = n0; cr1 = n1;
            }
        }
        for (; cc < c; ++cc) {
            const f32x4 s0 = *(const f32x4*)(P.send128() + (size_t)cc * 4096 + 8 * tid), s1 = *(const f32x4*)(P.send128() + (size_t)cc * 4096 + 8 * tid + 4);
            f32x4 n0, n1;
            n0[0] = p0[0] * cr0[0] - p0[1] * cr0[1] + s0[0]; n0[1] = p0[0] * cr0[1] + p0[1] * cr0[0] + s0[1];
            n0[2] = p0[2] * cr0[2] - p0[3] * cr0[3] + s0[2]; n0[3] = p0[2] * cr0[3] + p0[3] * cr0[2] + s0[3];
            n1[0] = p1[0] * cr1[0] - p1[1] * cr1[1] + s1[0]; n1[1] = p1[0] * cr1[1] + p1[1] * cr1[0] + s1[1];
            n1[2] = p1[2] * cr1[2] - p1[3] * cr1[3] + s1[2]; n1[3] = p1[2] * cr1[3] + p1[3] * cr1[2] + s1[3];
            cr0 = n0; cr1 = n1;
        }
        *(LAS f32x4*)(carry + 8 * tid) = cr0; *(LAS f32x4*)(carry + 8 * tid + 4) = cr1;
    }
    LAS unsigned char* XA = lds + wid * (32 * XA_STRIDE);
    if (lane < 32) { const u32x4 zz = {0u, 0u, 0u, 0u}; *(LAS u32x4*)(XA + lane * XA_STRIDE + 288) = zz; *(LAS u32x4*)(XA + lane * XA_STRIDE + 304) = zz; }
    __syncthreads();
    for (int gi = 0; gi < 4; ++gi) {
        const int g = wid * 4 + gi;
        SsmGroup G; ssm_load_group(P, g, lane, G);
        bf16x8 cf[5];
#pragma unroll
        for (int ks = 0; ks < 5; ++ks) cf[ks] = *(const bf16x8*)(P.cmT() + ((size_t)g * 16 + (lane & 15)) * 160 + 32 * ks + 8 * (lane >> 4));
        float xr[2], xi[2];
#pragma unroll
        for (int sp = 0; sp < 2; ++sp) {
            const int s = g * 64 + 32 * sp + (lane & 31);
            const float c0r = carry[2 * s], c0i = carry[2 * s + 1];
            if (lane < 32) { xr[sp] = c0r; xi[sp] = c0i; }
            else { const float pr = P.a64()[2 * s], pi = P.a64()[2 * s + 1]; const size_t o = ((size_t)c * 2048 + s) * 2;
                   xr[sp] = pr * c0r - pi * c0i + P.send0()[o]; xi[sp] = pr * c0i + pi * c0r + P.send0()[o + 1]; }
        }
        bf16x8 aops[4];
#pragma unroll
        for (int j = 0; j < 4; ++j) aops[j] = *(const bf16x8*)(P.z() + (size_t)(c * 128 + ssm_row_token(lane, j)) * DM + 512 + 16 * g + 8 * (lane >> 5));
        VM_WAIT0();
#pragma unroll
        for (int j = 0; j < 4; ++j) {
            const bf16x8 aop = aops[j];
            f32x16 bu[4];
#pragma unroll
            for (int cb = 0; cb < 4; ++cb) { f32x16 zz; for (int q = 0; q < 16; ++q) zz[q] = 0.f; bu[cb] = __builtin_amdgcn_mfma_f32_32x32x16_bf16(aop, G.bop[cb], zz, 0, 0, 0); }
            { const int r = lane & 31, xrow = 16 * ((r >> 2) & 1) + (r & 3) + 4 * (r >> 3); *(LAS bf16x8*)(XA + xrow * XA_STRIDE + 256 + 16 * (lane >> 5)) = aop; }
            LAS unsigned char* xw = XA + (16 * (lane >> 5)) * XA_STRIDE + 4 * (lane & 31);
#pragma unroll
            for (int i = 0; i < 16; ++i) {
#pragma unroll
                for (int sp = 0; sp < 2; ++sp) {
                    const float nxr = G.ar[sp] * xr[sp] - G.ai[sp] * xi[sp] + bu[sp][i];
                    const float nxi = G.ar[sp] * xi[sp] + G.ai[sp] * xr[sp] + bu[2 + sp][i];
                    xr[sp] = nxr; xi[sp] = nxi;
                    *(LAS unsigned*)(xw + i * XA_STRIDE + 128 * sp) = cvt_pk_bf16(nxr, nxi);
                }
            }
            asm volatile("s_waitcnt lgkmcnt(0)" ::: "memory");
#pragma unroll
            for (int rg = 0; rg < 2; ++rg) {
                f32x4 ay = {0.f, 0.f, 0.f, 0.f};
#pragma unroll
                for (int ks = 0; ks < 5; ++ks) {
                    const bf16x8 xf = *(const LAS bf16x8*)(XA + (16 * rg + (lane & 15)) * XA_STRIDE + 64 * ks + 16 * (lane >> 4));
                    ay = __builtin_amdgcn_mfma_f32_16x16x32_bf16(cf[ks], xf, ay, 0, 0, 0);
                }
                const int tok = c * 128 + 64 * rg + 16 * j + (lane & 15);
                u32x2 w; w.x = cvt_pk_bf16(gelu_tanh(ay[0]), gelu_tanh(ay[1])); w.y = cvt_pk_bf16(gelu_tanh(ay[2]), gelu_tanh(ay[3]));
                *(u32x2*)(P.ybuf() + (size_t)tok * 512 + 16 * g + 4 * (lane >> 4)) = w;
            }
            asm volatile("s_waitcnt lgkmcnt(0)" ::: "memory");
        }
    }
}


template <int W>
__device__ __forceinline__ void pool_channel(const Params& P, int c, int ch) {
    const int t0 = c * 128, pos0 = t0 & (SEQ - 1);
    const bf16_t* zc = P.z() + ch;
    float prev[16], cur[16];
#pragma unroll
    for (int i = 0; i < 16; ++i) prev[i] = (pos0 > 0) ? bf2f(zc[(size_t)(t0 - 16 + i) * DM]) : 0.f;
#pragma unroll 1
    for (int b = 0; b < 8; ++b) {
        const int tb = t0 + 16 * b, posb = pos0 + 16 * b;
#pragma unroll
        for (int i = 0; i < 16; ++i) cur[i] = bf2f(zc[(size_t)(tb + i) * DM]);
        VM_WAIT0();
#pragma unroll
        for (int i = 0; i < 16; ++i) {
            float a = 0.f;
#pragma unroll
            for (int j = 0; j < W; ++j) a += (i - j >= 0) ? cur[(i - j >= 0) ? i - j : 0] : prev[(i - j < 0) ? 16 + i - j : 0];
            const int pos = posb + i;
            const float inv = (pos + 1 < W) ? 1.0f / (float)(pos + 1) : (1.0f / (float)W);
            P.ycat()[(size_t)(tb + i) * DM + ch] = f2bf(a * inv - cur[i]);
        }
#pragma unroll
        for (int i = 0; i < 16; ++i) prev[i] = cur[i];
    }
}
__device__ __forceinline__ void phaseB_pool(const Params& P, int c, int tid) {
    const int gi = __builtin_amdgcn_readfirstlane(tid >> 7);
    if (gi == 0) pool_channel<2>(P, c, tid); else if (gi == 1) pool_channel<4>(P, c, tid); else if (gi == 2) pool_channel<8>(P, c, tid); else pool_channel<16>(P, c, tid);
}

__device__ __forceinline__ void phaseB_glu(const Params& P, LAS unsigned char* lds, int c, int tid) {
    const int wid = __builtin_amdgcn_readfirstlane(tid >> 6), lane = tid & 63, wr = wid >> 2, wc = wid & 3, fr = lane & 15, fq = lane >> 4;
#pragma unroll 1
    for (int nt_ = 0; nt_ < 2; ++nt_) {
        const int nt = (nt_ + c) & 1;
        StagePtrs sp; sp.a[2] = nullptr; sp.ksplit = 1 << 30; sp.bdelta = 0; sp.kt0 = (c >> 1) & 7; sp.nkt = 8;
#pragma unroll
        for (int j = 0; j < 2; ++j) { const int r = stage_row_a(wid, lane, j); sp.a[j] = (const char*)(P.ybuf() + (size_t)(c * 128 + r) * 512) + stage_chunk_off(r, lane); }
#pragma unroll
        for (int j = 0; j < 4; ++j) { const int r = stage_row_b(wid, lane, j); sp.b[j] = (const char*)(P.gluT() + (size_t)(nt * 256 + r) * 512) + stage_chunk_off(r, lane); }
        f32x4 acc[4][4]; acc_zero<4>(acc);
        f32x4 bb[4]; u32x2 ywa[4][4];
        const float* bres = P.glu_b + nt * 256 + wc * 64 + 4 * fq;
        const bf16_t* yres = P.ybuf() + ((size_t)c * 128 + wr * 64 + fr) * 512 + nt * 256 + wc * 64 + 4 * fq;
        auto pre = [&]() {
#pragma unroll
            for (int n = 0; n < 4; ++n) bb[n] = *(const f32x4*)(bres + n * 16);
#pragma unroll
            for (int m = 0; m < 4; ++m)
#pragma unroll
                for (int n = 0; n < 4; ++n) ywa[m][n] = *(const u32x2*)(yres + (size_t)m * 16 * 512 + n * 16);
            asm volatile("" ::: "memory");
        };
        gemm_core<4, 20>(lds, sp, 512 / 64, acc, wid, wr, wc, lane, nt_ == 0, pre);
        VM_WAIT0();
#pragma unroll
        for (int m = 0; m < 4; ++m) {
            const int row = c * 128 + wr * 64 + m * 16 + fr;
#pragma unroll
            for (int n = 0; n < 4; ++n) {
                const int col = nt * 256 + wc * 64 + n * 16 + 4 * fq;
                const u32x2 ywv = ywa[m][n];
                const float y0 = bflo(ywv.x), y1 = bfhi(ywv.x), y2 = bflo(ywv.y), y3 = bfhi(ywv.y);
                u32x2 w;
                w.x = cvt_pk_bf16(y0 / (1.0f + __expf(-(acc[m][n][0] + bb[n][0]))), y1 / (1.0f + __expf(-(acc[m][n][1] + bb[n][1]))));
                w.y = cvt_pk_bf16(y2 / (1.0f + __expf(-(acc[m][n][2] + bb[n][2]))), y3 / (1.0f + __expf(-(acc[m][n][3] + bb[n][3]))));
                *(u32x2*)(P.ycat() + (size_t)row * DM + 512 + col) = w;
            }
        }
    }
}

__device__ __forceinline__ void phaseB_wout(const Params& P, LAS unsigned char* lds, int c, int tid) {
    const int wid = __builtin_amdgcn_readfirstlane(tid >> 6), lane = tid & 63, wr = wid >> 2, wc = wid & 3, fr = lane & 15, fq = lane >> 4;
    LAS float* rowss = (LAS float*)(lds + MISC_OFF);
    LAS float* sspart = (LAS float*)(lds + MISC_OFF + 1024);
#pragma unroll 1
    for (int nt_ = 0; nt_ < 4; ++nt_) {
        const int nt = nt_;
        StagePtrs sp; sp.a[2] = nullptr; sp.ksplit = 1 << 30; sp.bdelta = 0; sp.kt0 = (c >> 2) & 15; sp.nkt = 16;
#pragma unroll
        for (int j = 0; j < 2; ++j) { const int r = stage_row_a(wid, lane, j); sp.a[j] = (const char*)(P.ycat() + (size_t)(c * 128 + r) * DM) + stage_chunk_off(r, lane); }
#pragma unroll
        for (int j = 0; j < 4; ++j) { const int r = stage_row_b(wid, lane, j); sp.b[j] = (const char*)(P.w_outT() + (size_t)(nt * 256 + r) * DM) + stage_chunk_off(r, lane); }
        f32x4 acc[4][4]; acc_zero<4>(acc);
        u32x2 xw[4][4];
        const bf16_t* xres = P.xb() + ((size_t)c * 128 + wr * 64 + fr) * DM + nt * 256 + wc * 64 + 4 * fq;
        auto pre = [&]() {
#pragma unroll
            for (int m = 0; m < 4; ++m)
#pragma unroll
                for (int n = 0; n < 4; ++n) xw[m][n] = *(const u32x2*)(xres + (size_t)m * 16 * DM + n * 16);
            asm volatile("" ::: "memory");
        };
        gemm_core<4, 16>(lds, sp, DM / 64, acc, wid, wr, wc, lane, nt_ == 0, pre);
        VM_WAIT0();
#pragma unroll
        for (int m = 0; m < 4; ++m) {
            const int lrow = wr * 64 + m * 16 + fr; const size_t row = (size_t)c * 128 + lrow;
            float ss = 0.f;
#pragma unroll
            for (int n = 0; n < 4; ++n) {
                const int col = nt * 256 + wc * 64 + n * 16 + 4 * fq;
                f32x4 v = acc[m][n]; v[0] += bflo(xw[m][n].x); v[1] += bfhi(xw[m][n].x); v[2] += bflo(xw[m][n].y); v[3] += bfhi(xw[m][n].y);
                u32x2 w; w.x = cvt_pk_bf16(v[0], v[1]); w.y = cvt_pk_bf16(v[2], v[3]);
                *(u32x2*)(P.x1b() + row * DM + col) = w;
                ss += v[0] * v[0] + v[1] * v[1] + v[2] * v[2] + v[3] * v[3];
            }
            ss += __shfl_xor(ss, 16); ss += __shfl_xor(ss, 32);
            if (fq == 0) sspart[lrow * 16 + nt * 4 + wc] = ss;
        }
    }
    VM_WAIT0();
    __syncthreads();
    if (tid < 128) { float t = 0.f;
#pragma unroll
        for (int q = 0; q < 16; ++q) t += sspart[tid * 16 + q];
        const float r = rsqrtf(t * (1.0f / DM) + EPSV); P.rstd2()[c * 128 + tid] = r; rowss[tid] = r; }
    __syncthreads();
}


#define LG_OFF (MISC_OFF + 1024)
#define CNT_OFF (MISC_OFF + 1024 + 10240)
__device__ __forceinline__ void phaseB_router(const Params& P, LAS unsigned char* lds, int c, int tid) {
    const int wid = tid >> 6, lane = tid & 63, l15 = lane & 15, fq = lane >> 4;
    LAS float* rowss = (LAS float*)(lds + MISC_OFF);
    LAS float* lg = (LAS float*)(lds + LG_OFF);
    LAS int* lcnt = (LAS int*)(lds + CNT_OFF);
    if (tid < 48) lcnt[tid] = 0;
    {
        f32x4 a0 = {0.f, 0.f, 0.f, 0.f}, a1 = {0.f, 0.f, 0.f, 0.f};
        const bf16_t* xr = P.x1b() + (size_t)(c * 128 + wid * 16 + l15) * DM + 8 * fq;
        const bf16_t* w0 = P.wrT() + (size_t)l15 * DM + 8 * fq;
        const bf16_t* w1 = P.wrT() + (size_t)(16 + l15) * DM + 8 * fq;
#pragma unroll 8
        for (int ks = 0; ks < 32; ++ks) {
            const bf16x8 xf = *(const bf16x8*)(xr + 32 * ks), f0 = *(const bf16x8*)(w0 + 32 * ks), f1 = *(const bf16x8*)(w1 + 32 * ks);
            a0 = __builtin_amdgcn_mfma_f32_16x16x32_bf16(f0, xf, a0, 0, 0, 0);
            a1 = __builtin_amdgcn_mfma_f32_16x16x32_bf16(f1, xf, a1, 0, 0, 0);
        }
        const int r = wid * 16 + l15;
#pragma unroll
        for (int q = 0; q < 4; ++q) lg[r * 20 + 4 * fq + q] = a0[q];
        if (fq == 0) {
#pragma unroll
            for (int q = 0; q < 4; ++q) lg[r * 20 + 16 + q] = a1[q];
        }
    }
    __syncthreads();
    int cls = 0, rank = 0; float wlo = 0.f, whi = 0.f;
    if (tid < 128) {
        const float rs = rowss[tid];
        float cl[4];
#pragma unroll
        for (int j = 0; j < 4; ++j) cl[j] = lg[tid * 20 + j] * rs + P.rc_b[j];
        int gi = 0; float mx = cl[0];
#pragma unroll
        for (int j = 1; j < 4; ++j) if (cl[j] > mx) { mx = cl[j]; gi = j; }
        float se = 0.f;
#pragma unroll
        for (int j = 0; j < 4; ++j) se += __expf(cl[j] - mx);
        const float pg = 1.0f / se;
        float f[4];
#pragma unroll
        for (int j = 0; j < 4; ++j) {
            float v = lg[tid * 20 + 4 + j] ;
            v = (gi == 1) ? lg[tid * 20 + 8 + j] : v; v = (gi == 2) ? lg[tid * 20 + 12 + j] : v; v = (gi == 3) ? lg[tid * 20 + 16 + j] : v;
            f[j] = v * rs + P.rf_b[gi * 4 + j];
        }
        int i0 = 0; float v0 = f[0];
#pragma unroll
        for (int j = 1; j < 4; ++j) if (f[j] > v0) { v0 = f[j]; i0 = j; }
        int i1 = -1; float v1 = 0.f;
#pragma unroll
        for (int j = 0; j < 4; ++j) if (j != i0 && (i1 < 0 || f[j] > v1)) { v1 = f[j]; i1 = j; }
        const float e1 = __expf(v1 - v0);
        const float wa = pg / (1.0f + e1), wb = pg * e1 / (1.0f + e1);
        const int lo = i0 < i1 ? i0 : i1, hi = i0 < i1 ? i1 : i0;
        wlo = (i0 < i1) ? wa : wb; whi = (i0 < i1) ? wb : wa;
        const int pidx = (lo == 0) ? (hi - 1) : ((lo == 1) ? (hi + 1) : 5);
        cls = gi * 6 + pidx;
        rank = __hip_atomic_fetch_add(&lcnt[cls], 1, __ATOMIC_RELAXED, __HIP_MEMORY_SCOPE_WORKGROUP);
    }
    __syncthreads();
    if (tid < 24) { const int n = lcnt[tid]; lcnt[24 + tid] = n ? (int)atomicAdd((unsigned*)P.ctl() + 64 + tid, (unsigned)n) : 0; }
    __syncthreads();
    if (tid < 128) {
        const int tok = c * 128 + tid;
        P.perm()[(size_t)cls * T_TOK + lcnt[24 + cls] + rank] = tok;
        P.tokw()[2 * tok] = wlo; P.tokw()[2 * tok + 1] = whi;
    }
}

#define C_ROWS 144
#define C_STAGE (C_ROWS * 128 + 32768)
#define C_MISC (3 * C_STAGE)
#define C_TOK_OFF (C_MISC)
#define C_RS_OFF (C_MISC + 576)
#define C_WL_OFF (C_MISC + 1152)
#define C_WH_OFF (C_MISC + 1728)
#define C_SS_OFF (C_MISC + 2304)
__device__ __forceinline__ void phaseC(const Params& P, LAS unsigned char* lds, int bid, int nblk, int tid_) {
    int tid = tid_;
    const int wid = __builtin_amdgcn_readfirstlane(tid >> 6), wr = wid >> 2, wc = wid & 3;
    const int rowbase = wr ? 80 : 0;
    LAS int* rowtok = (LAS int*)(lds + C_TOK_OFF);
    LAS float* rsv = (LAS float*)(lds + C_RS_OFF);
    LAS float* wlv = (LAS float*)(lds + C_WL_OFF);
    LAS float* whv = (LAS float*)(lds + C_WH_OFF);
    LAS float* sspart = (LAS float*)(lds + C_SS_OFF);
    const unsigned* gcnt = P.ctl() + 64;
    int total = 0;
    for (int k = 0; k < 24; ++k) total += ((int)gcnt[k] + C_ROWS - 1) / C_ROWS;
    for (int u = bid; u < total; u += nblk) {
        int cls = 0, j = u, cnt = 0;
        for (int k = 0; k < 24; ++k) { const int n = (int)gcnt[k], t = (n + C_ROWS - 1) / C_ROWS; if (j < t) { cls = k; cnt = n; break; } j -= t; }
        const int ntile = (cnt + C_ROWS - 1) / C_ROWS, rbeg = (int)(((long)cnt * j) / ntile), rend = (int)(((long)cnt * (j + 1)) / ntile), nvalid = rend - rbeg;
        __syncthreads();
        if (tid < C_ROWS) {
            const int r = tid < nvalid ? tid : nvalid - 1;
            const int tok = P.perm()[(size_t)cls * T_TOK + rbeg + r];
            rowtok[tid] = tok; rsv[tid] = P.rstd2()[tok]; wlv[tid] = P.tokw()[2 * tok]; whv[tid] = P.tokw()[2 * tok + 1];
        }
        __syncthreads();
        const int gi = cls / 6, pidx = cls - gi * 6;
        const int lo = pidx < 3 ? 0 : (pidx < 5 ? 1 : 2), hi = pidx < 3 ? pidx + 1 : (pidx < 5 ? pidx - 1 : 3);
        const int e_lo = gi * 4 + lo, e_hi = gi * 4 + hi;
        bf16_t* hid = P.hid() + (size_t)u * C_ROWS * 512;
        bf16_t* x2s = P.z() + (size_t)u * C_ROWS * DM;
        { asm volatile("" : "+v"(tid)); const int lane = tid & 63, fr = lane & 15, fq = lane >> 4;
#pragma unroll 1
        for (int s = 0; s < 2; ++s) {
            const int e = s ? e_hi : e_lo;
#pragma unroll 1
            for (int ch = 0; ch < 2; ++ch) {
                StagePtrs sp; sp.ksplit = 1 << 30; sp.bdelta = 0; sp.kt0 = 0; sp.nkt = 1 << 30;
#pragma unroll
                for (int q = 0; q < 3; ++q) { const int r = stage_row_a(wid, lane, q) < C_ROWS ? stage_row_a(wid, lane, q) : 0; sp.a[q] = (const char*)(P.x1b() + (size_t)rowtok[r] * DM) + stage_chunk_off(r, lane); }
#pragma unroll
                for (int q = 0; q < 4; ++q) { const int r = stage_row_b(wid, lane, q); sp.b[q] = (const char*)(P.wguT() + ((size_t)(e * 2 + ch) * 256 + r) * DM) + stage_chunk_off(r, lane); }
                f32x4 acc[5][4]; acc_zero<5>(acc);
                gemm_core<5>(lds, sp, DM / 64, acc, wid, wr, wc, lane, s == 0 && ch == 0);
#pragma unroll
                for (int m = 0; m < 5; ++m) if (m < 4 || wr == 0) {
                    const int r = rowbase + m * 16 + fr; const float rs = rsv[r], wsel = s ? whv[r] : wlv[r];
#pragma unroll
                    for (int n = 0; n < 2; ++n) {
                        float h[4];
#pragma unroll
                        for (int q = 0; q < 4; ++q) { const float g = acc[m][n][q] * rs, uu = acc[m][n + 2][q] * rs; h[q] = g / (1.0f + __expf(-g)) * uu * wsel; }
                        u32x2 w; w.x = cvt_pk_bf16(h[0], h[1]); w.y = cvt_pk_bf16(h[2], h[3]);
                        *(u32x2*)(hid + (size_t)r * 512 + 256 * s + 128 * ch + 32 * wc + 16 * n + 4 * fq) = w;
                    }
                    asm volatile("" ::: "memory");
                }
            }
        }
        }
        { asm volatile("" : "+v"(tid)); const int lane = tid & 63, fr = lane & 15, fq = lane >> 4;
        float ssr[5] = {0.f, 0.f, 0.f, 0.f, 0.f};
#pragma unroll 1
        for (int nt = 0; nt < 4; ++nt) {
            StagePtrs sp; sp.ksplit = 4; sp.bdelta = (long)(e_hi - e_lo) * DM * 256 * 2; sp.kt0 = 0; sp.nkt = 1 << 30;
#pragma unroll
            for (int q = 0; q < 3; ++q) { const int r = stage_row_a(wid, lane, q) < C_ROWS ? stage_row_a(wid, lane, q) : 0; sp.a[q] = (const char*)(hid + (size_t)r * 512) + stage_chunk_off(r, lane); }
#pragma unroll
            for (int q = 0; q < 4; ++q) { const int r = stage_row_b(wid, lane, q); sp.b[q] = (const char*)(P.wdT() + ((size_t)e_lo * DM + nt * 256 + r) * 256) + stage_chunk_off(r, lane); }
            f32x4 acc[5][4]; acc_zero<5>(acc);
            gemm_core<5>(lds, sp, 8, acc, wid, wr, wc, lane, nt == 0);
#pragma unroll
            for (int m = 0; m < 5; ++m) if (m < 4 || wr == 0) {
                const int r = rowbase + m * 16 + fr;
                if (r < nvalid) {
                    const bf16_t* xrow = P.x1b() + (size_t)rowtok[r] * DM + nt * 256 + wc * 64 + 4 * fq; bf16_t* srow = x2s + (size_t)r * DM + nt * 256 + wc * 64 + 4 * fq; float ss = 0.f;
                    u32x2 xwv[4];
#pragma unroll
                    for (int n = 0; n < 4; ++n) xwv[n] = *(const u32x2*)(xrow + n * 16);
                    VM_WAIT0();
#pragma unroll
                    for (int n = 0; n < 4; ++n) { const u32x2 xw = xwv[n]; f32x4 v = acc[m][n]; v[0] += bflo(xw.x); v[1] += bfhi(xw.x); v[2] += bflo(xw.y); v[3] += bfhi(xw.y);
                        u32x2 w; w.x = cvt_pk_bf16(v[0], v[1]); w.y = cvt_pk_bf16(v[2], v[3]); *(u32x2*)(srow + n * 16) = w; ss += v[0] * v[0] + v[1] * v[1] + v[2] * v[2] + v[3] * v[3]; }
                    ssr[m] += ss;
                }
                asm volatile("" ::: "memory");
            }
        }
#pragma unroll
        for (int m = 0; m < 5; ++m) if (m < 4 || wr == 0) {
            float ss = ssr[m]; ss += __shfl_xor(ss, 16); ss += __shfl_xor(ss, 32);
            if (fq == 0) sspart[(rowbase + m * 16 + fr) * 4 + wc] = ss;
        }
        }
        __syncthreads();
        { asm volatile("" : "+v"(tid)); const int lane = tid & 63, fr = lane & 15, fq = lane >> 4;
        float rs3[5];
#pragma unroll
        for (int m = 0; m < 5; ++m) { const int r = rowbase + m * 16 + fr; const int rr = (m < 4 || wr == 0) ? r : 0;
            const float tsum = (sspart[rr * 4] + sspart[rr * 4 + 1]) + (sspart[rr * 4 + 2] + sspart[rr * 4 + 3]); rs3[m] = rsqrtf(tsum * (1.0f / DM) + EPSV); }
        f32x4 gv[2][4]; u32x2 xwv[2][5][4];
#define C3_LOAD(buf, nt) do { \
            _Pragma("unroll") for (int n = 0; n < 4; ++n) gv[buf][n] = *(const f32x4*)(P.norm_final + (nt) * 256 + wc * 64 + 4 * fq + n * 16); \
            _Pragma("unroll") for (int m = 0; m < 5; ++m) if (m < 4 || wr == 0) { const int r = rowbase + m * 16 + fr; const bf16_t* srow = x2s + (size_t)(r < nvalid ? r : 0) * DM + (nt) * 256 + wc * 64 + 4 * fq; \
                _Pragma("unroll") for (int n = 0; n < 4; ++n) xwv[buf][m][n] = *(const u32x2*)(srow + n * 16); } } while (0)
        C3_LOAD(0, 0);
#pragma unroll
        for (int nt = 0; nt < 4; ++nt) {
            VM_WAIT0();
            if (nt + 1 < 4) C3_LOAD((nt + 1) & 1, nt + 1);
            asm volatile("" ::: "memory");
#pragma unroll
            for (int m = 0; m < 5; ++m) if (m < 4 || wr == 0) {
                const int r = rowbase + m * 16 + fr;
                if (r < nvalid) {
                    float* orow = P.out + (size_t)rowtok[r] * DM + nt * 256 + wc * 64 + 4 * fq;
#pragma unroll
                    for (int n = 0; n < 4; ++n) { const f32x4 g = gv[nt & 1][n]; const u32x2 xw = xwv[nt & 1][m][n]; const float rs = rs3[m];
                        f32x4 v; v[0] = bflo(xw.x) * rs * g[0]; v[1] = bfhi(xw.x) * rs * g[1]; v[2] = bflo(xw.y) * rs * g[2]; v[3] = bfhi(xw.y) * rs * g[3]; __builtin_nontemporal_store(v, (f32x4*)(orow + n * 16)); }
                }
            }
            asm volatile("" ::: "memory");
        }
#undef C3_LOAD
        }
    }
}


static void fill_params(Params& P, void* const* d_in, void* d_out, void* d_ws) {
    memset(&P, 0, sizeof(P));
    P.x = (const float*)d_in[0]; P.norm_mix = (const float*)d_in[1]; P.w_in = (const float*)d_in[2]; P.pool_w = (const float*)d_in[3]; P.pool_scale = (const float*)d_in[4];
    P.a_re = (const float*)d_in[5]; P.a_im = (const float*)d_in[6]; P.log_step = (const float*)d_in[7]; P.b_re = (const float*)d_in[8]; P.b_im = (const float*)d_in[9];
    P.c_re = (const float*)d_in[10]; P.c_im = (const float*)d_in[11]; P.ssm_d = (const float*)d_in[12]; P.glu_w = (const float*)d_in[13]; P.glu_b = (const float*)d_in[14];
    P.w_out = (const float*)d_in[15]; P.norm_ffn = (const float*)d_in[16]; P.rc_w = (const float*)d_in[17]; P.rc_b = (const float*)d_in[18]; P.rf_w = (const float*)d_in[19]; P.rf_b = (const float*)d_in[20];
    P.wg = (const float*)d_in[21]; P.wu = (const float*)d_in[22]; P.wd = (const float*)d_in[23]; P.norm_final = (const float*)d_in[24];
    P.out = (float*)d_out;
    P.ws = (char*)d_ws;
}
#define CTL_BYTES 65536

__global__ void __launch_bounds__(NTHR) mk_forward(Params P) {
    extern __shared__ __attribute__((aligned(16))) unsigned char lds_raw[];
    LAS unsigned char* lds = (LAS unsigned char*)lds_raw;
    const int bid = blockIdx.x, nblk = gridDim.x; int tid = threadIdx.x;
#define OPAQUE_TID() asm volatile("" : "+v"(tid))
    volatile LAS unsigned* xb_st = (volatile LAS unsigned*)(lds + LDS_BYTES - 16);
    if (tid < 4) xb_st[tid] = 0u;
    __syncthreads();
    const XcdBarrier xb = xcd_barrier_post(P.ctl(), xb_st);
    OPAQUE_TID();
    phase0_x(P, bid, nblk, tid);
    phase0_ssm(P, bid, nblk, tid);
    phase0_weights(P, bid, nblk, tid, (LAS float*)lds);
    xcd_barrier(xb);
    OPAQUE_TID();
    phaseA(P, lds, bid, nblk, tid);
    xcd_barrier(xb);
    OPAQUE_TID();
    phaseA2(P, bid, nblk, tid);
    xcd_barrier(xb);
    for (int c = bid; c < T_TOK / 128; c += nblk) {
        __syncthreads();
        OPAQUE_TID();
        phaseB_ssm(P, lds, c, tid);
        __syncthreads();
        OPAQUE_TID();
        phaseB_pool(P, c, tid);
        OPAQUE_TID();
        phaseB_glu(P, lds, c, tid);
        OPAQUE_TID();
        phaseB_wout(P, lds, c, tid);
        OPAQUE_TID();
        phaseB_router(P, lds, c, tid);
    }
    xcd_barrier(xb);
    OPAQUE_TID();
    phaseC(P, lds, bid, nblk, tid);
}

extern "C" void kernel_launch(void* const* d_in, const int* in_sizes, int n_in, void* d_out, int out_size, void* d_ws, size_t ws_size, hipStream_t stream) {
    static int grid_blocks = 0;
    if (!grid_blocks) {
        int dev = 0, cus = 0, per_cu = 0;
        (void)hipGetDevice(&dev);
        (void)hipDeviceGetAttribute(&cus, hipDeviceAttributeMultiprocessorCount, dev);
        (void)hipFuncSetAttribute((const void*)mk_forward, hipFuncAttributeMaxDynamicSharedMemorySize, LDS_BYTES);
        (void)hipOccupancyMaxActiveBlocksPerMultiprocessor(&per_cu, (const void*)mk_forward, NTHR, LDS_BYTES);
        if (per_cu < 1) per_cu = 1;
        grid_blocks = cus * per_cu; if (grid_blocks > 256) grid_blocks = 256;
    }
    Params P; fill_params(P, d_in, d_out, d_ws);
    (void)hipMemsetAsync(d_ws, 0, CTL_BYTES, stream);
    void* args[] = {&P};
    hipError_t e = hipLaunchCooperativeKernel((const void*)mk_forward, dim3(grid_blocks), dim3(NTHR), args, LDS_BYTES, stream);
    if (e != hipSuccess) fprintf(stderr, "cooperative launch failed: %s (grid %d)\n", hipGetErrorString(e), grid_blocks);
}
```

```cpp
#include <hip/hip_runtime.h>
#include <stdint.h>
#include <string.h>
#include <stdio.h>
#define T_TOK 32768
#define SEQ 8192
#define DM 1024
#define EPSV 1e-6f

#define LAS __attribute__((address_space(3)))
typedef unsigned short bf16_t;
typedef short bf16x8 __attribute__((ext_vector_type(8)));
typedef float f32x4 __attribute__((ext_vector_type(4)));
typedef float f32x16 __attribute__((ext_vector_type(16)));
typedef unsigned u32x2 __attribute__((ext_vector_type(2)));
typedef unsigned u32x4 __attribute__((ext_vector_type(4)));

#define NTHR 512
#define LDS_BYTES 163840
#define STAGE_B 49152
#define MISC_OFF (3 * STAGE_B)

__device__ __forceinline__ unsigned cvt_pk_bf16(float lo, float hi) { unsigned r; asm("v_cvt_pk_bf16_f32 %0, %1, %2" : "=v"(r) : "v"(lo), "v"(hi)); return r; }
__device__ __forceinline__ bf16_t f2bf(float f) { return (bf16_t)(cvt_pk_bf16(f, 0.f) & 0xffffu); }
__device__ __forceinline__ float bf2f(bf16_t h) { return __uint_as_float(((unsigned)h) << 16); }
__device__ __forceinline__ float bflo(unsigned w) { return __uint_as_float(w << 16); }
__device__ __forceinline__ float bfhi(unsigned w) { return __uint_as_float(w & 0xffff0000u); }

#define VM_WAIT0() do { asm volatile("" ::: "memory"); __builtin_amdgcn_s_waitcnt(0x0F70); asm volatile("" ::: "memory"); } while (0)

struct StagePtrs { const char* a[3]; const char* b[4]; long bdelta; int ksplit; int kt0; int nkt; };

__device__ __forceinline__ int stage_row_a(int wid, int lane, int i) { return (i < 2 ? (wid * 2 + i) * 8 : 128 + wid * 8) + (lane >> 3); }
__device__ __forceinline__ int stage_row_b(int wid, int lane, int i) { return (wid * 4 + i) * 8 + (lane >> 3); }
__device__ __forceinline__ int stage_chunk_off(int row, int lane) { return (((lane & 7) ^ ((row >> 1) & 7)) << 4); }

template <int MF0>
__device__ __forceinline__ void stage_issue(LAS unsigned char* lds, int s, const StagePtrs& sp, int kt_, int wid) {
    constexpr int ABYTES = (64 + 16 * MF0) * 128, SB = ABYTES + 32768;
    LAS unsigned char* base = lds + s * SB;
    int kt = kt_ + sp.kt0; kt = (kt >= sp.nkt) ? kt - sp.nkt : kt;
#pragma unroll
    for (int i = 0; i < 2; ++i) __builtin_amdgcn_global_load_lds((const unsigned*)(sp.a[i] + (size_t)kt * 128), (LAS unsigned*)(base + (wid * 2 + i) * 1024), 16, 0, 0);
    if (MF0 == 5 && wid < 2) __builtin_amdgcn_global_load_lds((const unsigned*)(sp.a[2] + (size_t)kt * 128), (LAS unsigned*)(base + (16 + wid) * 1024), 16, 0, 0);
    const long bofs = (kt < sp.ksplit) ? (long)kt * 128 : (long)(kt - sp.ksplit) * 128 + sp.bdelta;
#pragma unroll
    for (int i = 0; i < 4; ++i) __builtin_amdgcn_global_load_lds((const unsigned*)(sp.b[i] + bofs), (LAS unsigned*)(base + ABYTES + (wid * 4 + i) * 1024), 16, 0, 0);
}

struct NoPre { __device__ __forceinline__ void operator()() const {} };
#define GC_BAR() do { asm volatile("s_waitcnt lgkmcnt(0)" ::: "memory"); __builtin_amdgcn_s_barrier(); asm volatile("" ::: "memory"); } while (0)
#define GC_WAIT1() do { if (extra) asm volatile("s_waitcnt vmcnt(7)" ::: "memory"); else asm volatile("s_waitcnt vmcnt(6)" ::: "memory"); } while (0)
template <int MF0, int MODE, int NPRE, int NPRE1, class Pre>
__device__ __forceinline__ void gemm_ktile(LAS unsigned char* lds, const StagePtrs& sp, int nkt, int kt, int s, f32x4 (&acc)[MF0][4], int wid, int wr, int aoff, int boff, int offk0, int offk1, bool extra, Pre& pre) {
    constexpr int ABYTES = (64 + 16 * MF0) * 128, SB = ABYTES + 32768;
    if (MODE == 0) { if (kt + 2 < nkt) { const int s2 = (s >= 1) ? s - 1 : 2; stage_issue<MF0>(lds, s2, sp, kt + 2, wid); } }
    const LAS unsigned char* st = lds + s * SB;
    bf16x8 af[2][MF0], bfr[2][4];
#pragma unroll
    for (int ks = 0; ks < 2; ++ks) {
        const int ok = ks ? offk1 : offk0;
#pragma unroll
        for (int m = 0; m < MF0; ++m) if (m < 4 || wr == 0) af[ks][m] = *(const LAS bf16x8*)(st + aoff + m * 2048 + ok);
#pragma unroll
        for (int n = 0; n < 4; ++n) bfr[ks][n] = *(const LAS bf16x8*)(st + boff + n * 2048 + ok);
    }
    if (MODE == 0) { if (kt + 2 < nkt) GC_WAIT1(); else asm volatile("s_waitcnt vmcnt(0)" ::: "memory"); }
    if (MODE == 1) { pre(); if (NPRE1 != NPRE && wr == 1) asm volatile("s_waitcnt vmcnt(%0)" :: "n"(NPRE1) : "memory"); else asm volatile("s_waitcnt vmcnt(%0)" :: "n"(NPRE) : "memory"); }
    GC_BAR();
    __builtin_amdgcn_s_setprio(1);
#pragma unroll
    for (int ks = 0; ks < 2; ++ks)
#pragma unroll
        for (int m = 0; m < MF0; ++m) if (m < 4 || wr == 0) {
#pragma unroll
            for (int n = 0; n < 4; ++n) acc[m][n] = __builtin_amdgcn_mfma_f32_16x16x32_bf16(bfr[ks][n], af[ks][m], acc[m][n], 0, 0, 0); }
    __builtin_amdgcn_s_setprio(0);
    GC_BAR();
}
template <int MF0, int NPRE = 0, class Pre = NoPre, int NPRE1 = NPRE>
__device__ __forceinline__ void gemm_core(LAS unsigned char* lds, const StagePtrs& sp, int nkt, f32x4 (&acc)[MF0][4], int wid, int wr, int wc, int lane, bool drain = true, Pre pre = Pre()) {
    constexpr int ABYTES = (64 + 16 * MF0) * 128;
    const int fr = lane & 15, fq = lane >> 4, sw = fr >> 1;
    const int offk0 = fr * 128 + ((fq ^ sw) << 4), offk1 = fr * 128 + (((4 + fq) ^ sw) << 4);
    const int aoff = wr * (MF0 * 2048), boff = ABYTES + wc * 8192;
    const bool extra = (MF0 == 5) && (wid < 2);
    if (drain) asm volatile("s_waitcnt vmcnt(0)" ::: "memory");
    GC_BAR();
    stage_issue<MF0>(lds, 0, sp, 0, wid);
    if (nkt > 1) stage_issue<MF0>(lds, 1, sp, 1, wid);
    if (nkt > 1 && drain) GC_WAIT1(); else asm volatile("s_waitcnt vmcnt(0)" ::: "memory");
    GC_BAR();
    if (wr == 1) GC_BAR();
    int s = 0;
    const int nloop = NPRE > 0 ? nkt - 2 : nkt;
#pragma unroll 1
    for (int kt = 0; kt < nloop; ++kt) {
        gemm_ktile<MF0, 0, NPRE, NPRE1, Pre>(lds, sp, nkt, kt, s, acc, wid, wr, aoff, boff, offk0, offk1, extra, pre);
        s = (s == 2) ? 0 : s + 1;
    }
    if (NPRE > 0) {
        gemm_ktile<MF0, 1, NPRE, NPRE1, Pre>(lds, sp, nkt, nkt - 2, s, acc, wid, wr, aoff, boff, offk0, offk1, extra, pre);
        s = (s == 2) ? 0 : s + 1;
        gemm_ktile<MF0, 2, NPRE, NPRE1, Pre>(lds, sp, nkt, nkt - 1, s, acc, wid, wr, aoff, boff, offk0, offk1, extra, pre);
    }
    if (wr == 0) GC_BAR();
}
#undef GC_BAR
#undef GC_WAIT1
template <int MF0>
__device__ __forceinline__ void acc_zero(f32x4 (&acc)[MF0][4]) {
#pragma unroll
    for (int m = 0; m < MF0; ++m)
#pragma unroll
        for (int n = 0; n < 4; ++n) acc[m][n] = (f32x4){0.f, 0.f, 0.f, 0.f};
}


#define XB_TMO      128
#define XB_XCNT(j)  (256  + 64 * (j))
#define XB_XSUB(j)  (1280 + 64 * (j))
#define XB_XGEN(j)  (2304 + 64 * (j))
#define XB_TOP      3328
#define XB_TOPGEN   3392
#define XCD_BAR_WORDS 3456
#define XB_SPIN_CAP (1u << 18)

__device__ __forceinline__ unsigned xb_ld(unsigned* p)              { return __hip_atomic_load(p, __ATOMIC_RELAXED, __HIP_MEMORY_SCOPE_AGENT); }
__device__ __forceinline__ unsigned xb_add(unsigned* p, unsigned v) { return __hip_atomic_fetch_add(p, v, __ATOMIC_RELAXED, __HIP_MEMORY_SCOPE_AGENT); }
__device__ __forceinline__ unsigned xb_xcc_id() { return (unsigned)__builtin_amdgcn_s_getreg((3 << 11) | 20) & 0xFu; }
#define XB_SPIN(cond, bar) do { unsigned _sp = 0; while (cond) { __builtin_amdgcn_s_sleep(1); \
    if ((++_sp & 255u) == 0u) { if (xb_ld(&(bar)[XB_TMO])) break; if (_sp > XB_SPIN_CAP) { atomicAdd(&(bar)[XB_TMO], 1u); break; } } } } while (0)

struct XcdBarrier {
    unsigned* bar; unsigned x;
    volatile LAS unsigned* st;
};

__device__ __forceinline__ XcdBarrier xcd_barrier_post(unsigned* bar, volatile LAS unsigned* st) {
    XcdBarrier b; b.bar = bar; b.x = xb_xcc_id(); b.st = st;
    if (threadIdx.x == 0) (void)xb_add(&bar[XB_XCNT(b.x)], 1u);
    return b;
}
__device__ __forceinline__ void xcd_barrier_complete(unsigned* bar, unsigned x, unsigned& nloc, unsigned& nx) {
    const unsigned G = gridDim.x * gridDim.y * gridDim.z;
    unsigned sum, cnt, mine, sp = 0u;
    for (;;) {
        sum = 0u; cnt = 0u; mine = 0u;
#pragma unroll
        for (unsigned j = 0; j < 16; ++j) { const unsigned c = xb_ld(&bar[XB_XCNT(j)]); sum += c; cnt += (c > 0u) ? 1u : 0u; mine = (j == x) ? c : mine; }
        if (sum == G) break;
        __builtin_amdgcn_s_sleep(1);
        if ((++sp & 255u) == 0u) { if (xb_ld(&bar[XB_TMO])) break; if (sp > XB_SPIN_CAP) { atomicAdd(&bar[XB_TMO], 1u); break; } }
    }
    nloc = mine > 0u ? mine : 1u; nx = cnt > 0u ? cnt : 1u;
}

__device__ __forceinline__ void xcd_barrier(const XcdBarrier& b) {
    asm volatile("s_waitcnt vmcnt(0)" ::: "memory");
    __syncthreads();
    if (threadIdx.x == 0) {
        unsigned* bar = b.bar;
        __builtin_amdgcn_s_waitcnt(0);
        unsigned nloc = b.st[0], nx = b.st[1];
        if (nloc == 0u) { xcd_barrier_complete(bar, b.x, nloc, nx); b.st[0] = nloc; b.st[1] = nx; }
        const unsigned old = xb_add(&bar[XB_XSUB(b.x)], 1u);
        const unsigned gen = old / nloc;
        if (old + 1u == (gen + 1u) * nloc) {
            __builtin_amdgcn_fence(__ATOMIC_RELEASE, "agent");
            asm volatile("s_waitcnt vmcnt(0)" ::: "memory");
            const unsigned og = xb_add(&bar[XB_TOP], 1u);
            const unsigned tg = og / nx;
            if (og + 1u == (tg + 1u) * nx) xb_add(&bar[XB_TOPGEN], 1u);
            else XB_SPIN(xb_ld(&bar[XB_TOPGEN]) == tg, bar);
            __builtin_amdgcn_fence(__ATOMIC_ACQUIRE, "agent");
            xb_add(&bar[XB_XGEN(b.x)], 1u);
            asm volatile("s_waitcnt vmcnt(0)" ::: "memory");
        } else {
            XB_SPIN(xb_ld(&bar[XB_XGEN(b.x)]) == gen, bar);
            __builtin_amdgcn_fence(__ATOMIC_ACQUIRE, "agent");
            asm volatile("s_waitcnt vmcnt(0)" ::: "memory");
        }
    }
    __syncthreads();
}


struct Params {
    const float* x; const float* norm_mix; const float* w_in; const float* pool_w; const float* pool_scale;
    const float* a_re; const float* a_im; const float* log_step; const float* b_re; const float* b_im; const float* c_re; const float* c_im; const float* ssm_d;
    const float* glu_w; const float* glu_b; const float* w_out; const float* norm_ffn; const float* rc_w; const float* rc_b; const float* rf_w; const float* rf_b;
    const float* wg; const float* wu; const float* wd; const float* norm_final;
    float* out;
    char* ws;
#define WS_MB(x) ((size_t)(x) << 20)
    __device__ __forceinline__ unsigned* ctl() const { return (unsigned*)ws; }
    __device__ __forceinline__ float* rstd1() const { return (float*)(ws + WS_MB(1)); }
    __device__ __forceinline__ float* rstd2() const { return (float*)(ws + WS_MB(1) + 131072); }
    __device__ __forceinline__ float* tokw() const { return (float*)(ws + WS_MB(1) + 262144); }
    __device__ __forceinline__ float* abar() const { return (float*)(ws + WS_MB(2)); }
    __device__ __forceinline__ float* a64() const { return (float*)(ws + WS_MB(2) + 16384); }
    __device__ __forceinline__ float* a128() const { return (float*)(ws + WS_MB(2) + 32768); }
    __device__ __forceinline__ bf16_t* bbT() const { return (bf16_t*)(ws + WS_MB(2) + 65536); }
    __device__ __forceinline__ bf16_t* cmT() const { return (bf16_t*)(ws + WS_MB(2) + 65536 + 131072); }
    __device__ __forceinline__ bf16_t* wrT() const { return (bf16_t*)(ws + WS_MB(3)); }
    __device__ __forceinline__ float* send0() const { return (float*)(ws + WS_MB(4)); }
    __device__ __forceinline__ float* send128() const { return (float*)(ws + WS_MB(8)); }
    __device__ __forceinline__ int* perm() const { return (int*)(ws + WS_MB(12)); }
    __device__ __forceinline__ bf16_t* w_inT() const { return (bf16_t*)(ws + WS_MB(16)); }
    __device__ __forceinline__ bf16_t* gluT() const { return (bf16_t*)(ws + WS_MB(18)); }
    __device__ __forceinline__ bf16_t* w_outT() const { return (bf16_t*)(ws + WS_MB(19)); }
    __device__ __forceinline__ bf16_t* wguT() const { return (bf16_t*)(ws + WS_MB(24)); }
    __device__ __forceinline__ bf16_t* wdT() const { return (bf16_t*)(ws + WS_MB(40)); }
    __device__ __forceinline__ bf16_t* hid() const { return (bf16_t*)(ws + WS_MB(48)); }
    __device__ __forceinline__ bf16_t* xb() const { return (bf16_t*)(ws + WS_MB(96)); }
    __device__ __forceinline__ bf16_t* z() const { return (bf16_t*)(ws + WS_MB(160)); }
    __device__ __forceinline__ bf16_t* ycat() const { return (bf16_t*)(ws + WS_MB(224)); }
    __device__ __forceinline__ bf16_t* x1b() const { return (bf16_t*)(ws + WS_MB(288)); }
    __device__ __forceinline__ bf16_t* ybuf() const { return (bf16_t*)(ws + WS_MB(352)); }
};

__device__ __forceinline__ void phase0_x(const Params& P, int bid, int nblk, int tid) {
    const int wave = tid >> 6, lane = tid & 63;
    for (int row = (bid * 8 + wave) * 4; row < T_TOK; row += nblk * 32) {
        f32x4 v[4][4];
#pragma unroll
        for (int r = 0; r < 4; ++r)
#pragma unroll
            for (int i = 0; i < 4; ++i) v[r][i] = __builtin_nontemporal_load((const f32x4*)(P.x + (size_t)(row + r) * DM + i * 256 + lane * 4));
        VM_WAIT0();
#pragma unroll
        for (int r = 0; r < 4; ++r) {
            float s = 0.f;
#pragma unroll
            for (int i = 0; i < 4; ++i) s += v[r][i][0] * v[r][i][0] + v[r][i][1] * v[r][i][1] + v[r][i][2] * v[r][i][2] + v[r][i][3] * v[r][i][3];
#pragma unroll
            for (int o = 32; o > 0; o >>= 1) s += __shfl_xor(s, o);
            if (lane == 0) P.rstd1()[row + r] = rsqrtf(s * (1.0f / DM) + EPSV);
            bf16_t* xo = P.xb() + (size_t)(row + r) * DM;
#pragma unroll
            for (int i = 0; i < 4; ++i) { u32x2 w; w.x = cvt_pk_bf16(v[r][i][0], v[r][i][1]); w.y = cvt_pk_bf16(v[r][i][2], v[r][i][3]); *(u32x2*)(xo + i * 256 + lane * 4) = w; }
        }
    }
}

struct TrJob { const float* sa; const float* sb; const float* scale; bf16_t* dst; int lds; int ldd; };
__device__ __forceinline__ void tr_describe(const Params& P, int job, TrJob& J) {
    if (job < 128) { const int n0 = 512 + (job >> 4) * 64, k0 = (job & 15) * 64;
        J.sa = P.w_in + (size_t)k0 * DM + n0; J.sb = J.sa + 32; J.scale = P.norm_mix + k0; J.dst = P.w_inT() + (size_t)n0 * DM + k0; J.lds = DM; J.ldd = DM; }
    else if (job < 192) { const int j = job - 128, n0 = (j >> 3) * 64, k0 = (j & 7) * 64;
        J.sa = P.glu_w + (size_t)k0 * 512 + n0; J.sb = J.sa + 32; J.scale = nullptr; J.dst = P.gluT() + (size_t)n0 * 512 + k0; J.lds = 512; J.ldd = 512; }
    else if (job < 448) { const int j = job - 192, n0 = (j >> 4) * 64, k0 = (j & 15) * 64;
        J.sa = P.w_out + (size_t)k0 * DM + n0; J.sb = J.sa + 32; J.scale = nullptr; J.dst = P.w_outT() + (size_t)n0 * DM + k0; J.lds = DM; J.ldd = DM; }
    else if (job < 2496) { const int j = job - 448, kt = j & 15, wc = (j >> 4) & 3, ch = (j >> 6) & 1, e = j >> 7, k0 = kt * 64, f0 = 128 * ch + 32 * wc;
        J.sa = P.wg + ((size_t)e * DM + k0) * 256 + f0; J.sb = P.wu + ((size_t)e * DM + k0) * 256 + f0; J.scale = P.norm_ffn + k0;
        J.dst = P.wguT() + ((size_t)((e * 2 + ch) * 256 + wc * 64)) * DM + k0; J.lds = 256; J.ldd = DM; }
    else { const int j = job - 2496, ft = j & 3, nt = (j >> 2) & 15, e = j >> 6, f0 = ft * 64, n0 = nt * 64;
        J.sa = P.wd + ((size_t)e * 256 + f0) * DM + n0; J.sb = J.sa + 32; J.scale = nullptr; J.dst = P.wdT() + ((size_t)e * DM + n0) * 256 + f0; J.lds = DM; J.ldd = 256; }
}
__device__ __forceinline__ void tr_round(const Params& P, int job0, int jstep, int njobs_end, LAS float* tl, int tid) {
    TrJob J[4]; f32x4 a[4], b[4]; float sc[4];
    const int k = tid >> 3, c8 = (tid & 7) * 8;
#pragma unroll
    for (int q = 0; q < 4; ++q) { const int job = job0 + q * jstep; if (job < njobs_end) { tr_describe(P, job, J[q]);
        const float* src = (c8 < 32 ? J[q].sa + c8 : J[q].sb + (c8 - 32)) + (size_t)k * J[q].lds;
        a[q] = __builtin_nontemporal_load((const f32x4*)src); b[q] = __builtin_nontemporal_load((const f32x4*)(src + 4));
        sc[q] = J[q].scale ? J[q].scale[k] : 1.0f; } }
    VM_WAIT0();
#pragma unroll
    for (int q = 0; q < 4; ++q) if (job0 + q * jstep < njobs_end) { LAS float* t = tl + q * (64 * 65) + k * 65 + c8;
        t[0] = a[q][0] * sc[q]; t[1] = a[q][1] * sc[q]; t[2] = a[q][2] * sc[q]; t[3] = a[q][3] * sc[q]; t[4] = b[q][0] * sc[q]; t[5] = b[q][1] * sc[q]; t[6] = b[q][2] * sc[q]; t[7] = b[q][3] * sc[q]; }
    __syncthreads();
    const int n = tid >> 3, k8 = (tid & 7) * 8;
#pragma unroll
    for (int q = 0; q < 4; ++q) if (job0 + q * jstep < njobs_end) { const LAS float* t = tl + q * (64 * 65);
        u32x4 w;
        w.x = cvt_pk_bf16(t[(k8 + 0) * 65 + n], t[(k8 + 1) * 65 + n]); w.y = cvt_pk_bf16(t[(k8 + 2) * 65 + n], t[(k8 + 3) * 65 + n]);
        w.z = cvt_pk_bf16(t[(k8 + 4) * 65 + n], t[(k8 + 5) * 65 + n]); w.w = cvt_pk_bf16(t[(k8 + 6) * 65 + n], t[(k8 + 7) * 65 + n]);
        *(u32x4*)(J[q].dst + (size_t)n * J[q].ldd + k8) = w; }
    __syncthreads();
}

#define N_TR_JOBS 3648
__device__ __forceinline__ void phase0_weights(const Params& P, int bid, int nblk, int tid, LAS float* tl) {
    for (int job = bid; job < 3520; job += 4 * nblk) tr_round(P, job, nblk, 3520, tl, tid);
    for (int job = 3520 + bid; job < N_TR_JOBS; job += nblk) {
        {
            const int j = job - 3520, n0 = (j >> 4) * 64, k0 = (j & 15) * 64, g = n0 >> 7, d0 = n0 & 127;
            LAS float* wa = tl + 64 * 65;
            LAS float* pb = wa + 64 * 129;
            for (int i = tid; i < 64 * 32; i += NTHR) { const int k = i >> 5, c4 = (i & 31) * 4; const f32x4 v = *(const f32x4*)(P.w_in + (size_t)(k0 + k) * DM + 128 * g + c4);
                LAS float* t = wa + k * 129 + c4; t[0] = v[0]; t[1] = v[1]; t[2] = v[2]; t[3] = v[3]; }
            for (int i = tid; i < 128 * 16; i += NTHR) { const int cc = i >> 4, d4 = (i & 15) * 4; const f32x4 v = *(const f32x4*)(P.pool_w + ((size_t)g * 128 + cc) * 128 + d0 + d4);
                LAS float* t = pb + cc * 65 + d4; t[0] = v[0]; t[1] = v[1]; t[2] = v[2]; t[3] = v[3]; }
            __syncthreads();
            {
                const int k = tid >> 3, dl = tid & 7; float a[8];
#pragma unroll
                for (int q = 0; q < 8; ++q) a[q] = 0.f;
                for (int cc = 0; cc < 128; ++cc) { const float wv = wa[k * 129 + cc];
#pragma unroll
                    for (int q = 0; q < 8; ++q) a[q] += wv * pb[cc * 65 + dl + 8 * q]; }
                const float nm = P.norm_mix[k0 + k];
#pragma unroll
                for (int q = 0; q < 8; ++q) tl[k * 65 + dl + 8 * q] = a[q] * nm * P.pool_scale[n0 + dl + 8 * q];
            }
            __syncthreads();
            { const int n = tid >> 3, k8 = (tid & 7) * 8; u32x4 w;
              w.x = cvt_pk_bf16(tl[(k8 + 0) * 65 + n], tl[(k8 + 1) * 65 + n]); w.y = cvt_pk_bf16(tl[(k8 + 2) * 65 + n], tl[(k8 + 3) * 65 + n]);
              w.z = cvt_pk_bf16(tl[(k8 + 4) * 65 + n], tl[(k8 + 5) * 65 + n]); w.w = cvt_pk_bf16(tl[(k8 + 6) * 65 + n], tl[(k8 + 7) * 65 + n]);
              *(u32x4*)(P.w_inT() + (size_t)(n0 + n) * DM + k0 + k8) = w; }
            __syncthreads();
        }
    }
    for (int i = bid * NTHR + tid; i < 32 * DM; i += nblk * NTHR) {
        const int j = i >> 10, k = i & 1023; float v = 0.f;
        if (j < 4) v = P.norm_ffn[k] * P.rc_w[k * 4 + j]; else if (j < 20) v = P.norm_ffn[k] * P.rf_w[k * 16 + j - 4];
        P.wrT()[i] = f2bf(v);
    }
}

__device__ __forceinline__ void phaseA_tile(const Params& P, LAS unsigned char* lds, int mt, int nt0, int tid) {
    const int wid = __builtin_amdgcn_readfirstlane(tid >> 6), lane = tid & 63, wr = wid >> 2, wc = wid & 3, fr = lane & 15, fq = lane >> 4;
#pragma unroll 1
    for (int nt_ = 0; nt_ < 4; ++nt_) {
        const int nt = (nt_ + nt0) & 3;
        StagePtrs sp; sp.a[2] = nullptr; sp.ksplit = 1 << 30; sp.bdelta = 0; sp.kt0 = 0; sp.nkt = 1 << 30;
#pragma unroll
        for (int j = 0; j < 2; ++j) { const int r = stage_row_a(wid, lane, j); sp.a[j] = (const char*)(P.xb() + (size_t)(mt * 128 + r) * DM) + stage_chunk_off(r, lane); }
#pragma unroll
        for (int j = 0; j < 4; ++j) { const int r = stage_row_b(wid, lane, j); sp.b[j] = (const char*)(P.w_inT() + (size_t)(nt * 256 + r) * DM) + stage_chunk_off(r, lane); }
        f32x4 acc[4][4]; acc_zero<4>(acc);
        float rsm[4];
        const float* rsp = P.rstd1() + mt * 128 + wr * 64 + fr;
        auto pre = [&]() {
#pragma unroll
            for (int m = 0; m < 4; ++m) rsm[m] = rsp[m * 16];
            asm volatile("" ::: "memory");
        };
        gemm_core<4, 4>(lds, sp, DM / 64, acc, wid, wr, wc, lane, false, pre);
        VM_WAIT0();
#pragma unroll
        for (int m = 0; m < 4; ++m) {
            const int row = mt * 128 + wr * 64 + m * 16 + fr; const float rs = rsm[m];
            bf16_t* zr = P.z() + (size_t)row * DM + nt * 256 + wc * 64 + 4 * fq;
#pragma unroll
            for (int n = 0; n < 4; ++n) { u32x2 w; w.x = cvt_pk_bf16(acc[m][n][0] * rs, acc[m][n][1] * rs); w.y = cvt_pk_bf16(acc[m][n][2] * rs, acc[m][n][3] * rs); *(u32x2*)(zr + n * 16) = w; }
        }
    }
}
__device__ __forceinline__ void phaseA(const Params& P, LAS unsigned char* lds, int bid, int nblk, int tid) {
    for (int mt = bid; mt < T_TOK / 128; mt += nblk) phaseA_tile(P, lds, mt, mt >> 3, tid);
}


__device__ __forceinline__ void phase0_ssm(const Params& P, int bid, int nblk, int tid) {
    for (int i = bid * NTHR + tid; i < 2048; i += nblk * NTHR) {
        const int g = i >> 6;
        const double lr = (double)P.a_re[i], li = (double)P.a_im[i], step = exp((double)P.log_step[g]);
        const double mag = exp(lr * step), ar = mag * cos(li * step), ai = mag * sin(li * step);
        const double den = lr * lr + li * li, nr = ar - 1.0, ni = ai;
        const double qr = (nr * lr + ni * li) / den, qi = (ni * lr - nr * li) / den;
        P.abar()[2 * i] = (float)ar; P.abar()[2 * i + 1] = (float)ai;
        const double m64 = exp(64.0 * lr * step), m128 = exp(128.0 * lr * step);
        P.a64()[2 * i] = (float)(m64 * cos(64.0 * li * step)); P.a64()[2 * i + 1] = (float)(m64 * sin(64.0 * li * step));
        P.a128()[2 * i] = (float)(m128 * cos(128.0 * li * step)); P.a128()[2 * i + 1] = (float)(m128 * sin(128.0 * li * step));
        const int p = i & 63;
        float brv[16], biv[16];
#pragma unroll
        for (int h = 0; h < 16; ++h) { brv[h] = P.b_re[i * 16 + h]; biv[h] = P.b_im[i * 16 + h]; }
        VM_WAIT0();
#pragma unroll
        for (int h = 0; h < 16; ++h) {
            const double br = (double)brv[h], bi = (double)biv[h];
            P.bbT()[((size_t)g * 128 + p) * 16 + h] = f2bf((float)(qr * br - qi * bi));
            P.bbT()[((size_t)g * 128 + 64 + p) * 16 + h] = f2bf((float)(qr * bi + qi * br));
        }
    }
    for (int i = bid * NTHR + tid; i < 32 * 16 * 160; i += nblk * NTHR) {
        const int k = i % 160, gh = i / 160, h = gh & 15;
        float v = 0.f;
        if (k < 128) v = (k & 1) ? -P.c_im[gh * 64 + (k >> 1)] : P.c_re[gh * 64 + (k >> 1)];
        else if (k - 128 == h) v = P.ssm_d[gh];
        P.cmT()[i] = f2bf(v);
    }
}

struct SsmGroup { bf16x8 bop[4]; float ar[2], ai[2]; };
__device__ __forceinline__ void ssm_load_group(const Params& P, int g, int lane, SsmGroup& G) {
#pragma unroll
    for (int cb = 0; cb < 4; ++cb) G.bop[cb] = *(const bf16x8*)(P.bbT() + ((size_t)g * 128 + 32 * cb + (lane & 31)) * 16 + 8 * (lane >> 5));
#pragma unroll
    for (int sp = 0; sp < 2; ++sp) { const int s = g * 64 + 32 * sp + (lane & 31); G.ar[sp] = P.abar()[2 * s]; G.ai[sp] = P.abar()[2 * s + 1]; }
}
__device__ __forceinline__ int ssm_row_token(int lane, int j) { const int r = lane & 31; return 64 * ((r >> 2) & 1) + 16 * j + (r & 3) + 4 * (r >> 3); }

__device__ __forceinline__ void phaseA2_chunk(const Params& P, int c, int tid) {
    const int wid = tid >> 6, lane = tid & 63;
    {
        for (int gi = 0; gi < 4; ++gi) {
            const int g = wid * 4 + gi;
            SsmGroup G; ssm_load_group(P, g, lane, G);
            float xr[2] = {0.f, 0.f}, xi[2] = {0.f, 0.f};
#pragma unroll 1
            for (int j = 0; j < 4; ++j) {
                const int tok = c * 128 + ssm_row_token(lane, j);
                const bf16x8 aop = *(const bf16x8*)(P.z() + (size_t)tok * DM + 512 + 16 * g + 8 * (lane >> 5));
                f32x16 bu[4];
#pragma unroll
                for (int cb = 0; cb < 4; ++cb) { f32x16 zz; for (int q = 0; q < 16; ++q) zz[q] = 0.f; bu[cb] = __builtin_amdgcn_mfma_f32_32x32x16_bf16(aop, G.bop[cb], zz, 0, 0, 0); }
#pragma unroll
                for (int i = 0; i < 16; ++i)
#pragma unroll
                    for (int sp = 0; sp < 2; ++sp) {
                        const float nxr = G.ar[sp] * xr[sp] - G.ai[sp] * xi[sp] + bu[sp][i];
                        const float nxi = G.ar[sp] * xi[sp] + G.ai[sp] * xr[sp] + bu[2 + sp][i];
                        xr[sp] = nxr; xi[sp] = nxi;
                    }
            }
#pragma unroll
            for (int sp = 0; sp < 2; ++sp) {
                const float s1r = __shfl(xr[sp], (lane & 31) + 32), s1i = __shfl(xi[sp], (lane & 31) + 32);
                if (lane < 32) {
                    const int s = g * 64 + 32 * sp + lane;
                    const float pr = P.a64()[2 * s], pi = P.a64()[2 * s + 1];
                    VM_WAIT0();
                    const size_t o = ((size_t)c * 2048 + s) * 2;
                    P.send0()[o] = xr[sp]; P.send0()[o + 1] = xi[sp];
                    P.send128()[o] = pr * xr[sp] - pi * xi[sp] + s1r; P.send128()[o + 1] = pr * xi[sp] + pi * xr[sp] + s1i;
                }
            }
        }
    }
}

__device__ __forceinline__ void phaseA2(const Params& P, LAS unsigned char* lds_unused, int bid, int nblk, int tid) {
    for (int c = bid; c < T_TOK / 128; c += nblk) phaseA2_chunk(P, c, tid);
}

#define XA_STRIDE 336
__device__ __forceinline__ float gelu_tanh(float y) { const float a = 1.5957691216057308f * (y + 0.044715f * y * y * y); return y / (1.0f + __expf(-a)); }

__device__ __forceinline__ void phaseB_ssm(const Params& P, LAS unsigned char* lds, int c, int tid) {
    const int wid = tid >> 6, lane = tid & 63;
    LAS float* carry = (LAS float*)(lds + 86016);
    {
        const int c0 = c & ~63;
        f32x4 cr0 = {0.f, 0.f, 0.f, 0.f}, cr1 = {0.f, 0.f, 0.f, 0.f};
        const f32x4 p0 = *(const f32x4*)(P.a128() + 8 * tid), p1 = *(const f32x4*)(P.a128() + 8 * tid + 4);
        int cc = c0;
        for (; cc + 8 <= c; cc += 8) {
            f32x4 s0[8], s1[8];
#pragma unroll
            for (int q = 0; q < 8; ++q) { s0[q] = *(const f32x4*)(P.send128() + (size_t)(cc + q) * 4096 + 8 * tid); s1[q] = *(const f32x4*)(P.send128() + (size_t)(cc + q) * 4096 + 8 * tid + 4); }
#pragma unroll
            for (int q = 0; q < 8; ++q) {
                f32x4 n0, n1;
                n0[0] = p0[0] * cr0[0] - p0[1] * cr0[1] + s0[q][0]; n0[1] = p0[0] * cr0[1] + p0[1] * cr0[0] + s0[q][1];
                n0[2] = p0[2] * cr0[2] - p0[3] * cr0[3] + s0[q][2]; n0[3] = p0[2] * cr0[3] + p0[3] * cr0[2] + s0[q][3];
                n1[0] = p1[0] * cr1[0] - p1[1] * cr1[1] + s1[q][0]; n1[1] = p1[0] * cr1[1] + p1[1] * cr1[0] + s1[q][1];
                n1[2] = p1[2] * cr1[2] - p1[3] * cr1[3] + s1[q][2]; n1[3] = p1[2] * cr1[3] + p1[3] * cr1[2] + s1[q][3];
                cr0 = n0; cr1 = n1;
            }
        }
        for (; cc < c; ++cc) {
            const f32x4 s0 = *(const f32x4*)(P.send128() + (size_t)cc * 4096 + 8 * tid), s1 = *(const f32x4*)(P.send128() + (size_t)cc * 4096 + 8 * tid + 4);
            f32x4 n0, n1;
            n0[0] = p0[0] * cr0[0] - p0[1] * cr0[1] + s0[0]; n0[1] = p0[0] * cr0[1] + p0[1] * cr0[0] + s0[1];
            n0[2] = p0[2] * cr0[2] - p0[3] * cr0[3] + s0[2]; n0[3] = p0[2] * cr0[3] + p0[3] * cr0[2] + s0[3];
            n1[0] = p1[0] * cr1[0] - p1[1] * cr1[1] + s1[0]; n1[1] = p1[0] * cr1[1] + p1[1] * cr1[0] + s1[1];
            n1[2] = p1[2] * cr1[2] - p1[3] * cr1[3] + s1[2]; n1[3] = p1[2] * cr1[3] + p1[3] * cr1[2] + s1[3];
            cr0 = n0; cr1 = n1;
        }
        *(LAS f32x4*)(carry + 8 * tid) = cr0; *(LAS f32x4*)(carry + 8 * tid + 4) = cr1;
    }
    LAS unsigned char* XA = lds + wid * (32 * XA_STRIDE);
    if (lane < 32) { const u32x4 zz = {0u, 0u, 0u, 0u}; *(LAS u32x4*)(XA + lane * XA_STRIDE + 288) = zz; *(LAS u32x4*)(XA + lane * XA_STRIDE + 304) = zz; }
    __syncthreads();
    for (int gi = 0; gi < 4; ++gi) {
        const int g = wid * 4 + gi;
        SsmGroup G; ssm_load_group(P, g, lane, G);
        bf16x8 cf[5];
#pragma unroll
        for (int ks = 0; ks < 5; ++ks) cf[ks] = *(const bf16x8*)(P.cmT() + ((size_t)g * 16 + (lane & 15)) * 160 + 32 * ks + 8 * (lane >> 4));
        float xr[2], xi[2];
#pragma unroll
        for (int sp = 0; sp < 2; ++sp) {
            const int s = g * 64 + 32 * sp + (lane & 31);
            const float c0r = carry[2 * s], c0i = carry[2 * s + 1];
            if (lane < 32) { xr[sp] = c0r; xi[sp] = c0i; }
            else { const float pr = P.a64()[2 * s], pi = P.a64()[2 * s + 1]; const size_t o = ((size_t)c * 2048 + s) * 2;
                   xr[sp] = pr * c0r - pi * c0i + P.send0()[o]; xi[sp] = pr * c0i + pi * c0r + P.send0()[o + 1]; }
        }
        bf16x8 aops[4];
#pragma unroll
        for (int j = 0; j < 4; ++j) aops[j] = *(const bf16x8*)(P.z() + (size_t)(c * 128 + ssm_row_token(lane, j)) * DM + 512 + 16 * g + 8 * (lane >> 5));
        VM_WAIT0();
#pragma unroll
        for (int j = 0; j < 4; ++j) {
            const bf16x8 aop = aops[j];
            f32x16 bu[4];
#pragma unroll
            for (int cb = 0; cb < 4; ++cb) { f32x16 zz; for (int q = 0; q < 16; ++q) zz[q] = 0.f; bu[cb] = __builtin_amdgcn_mfma_f32_32x32x16_bf16(aop, G.bop[cb], zz, 0, 0, 0); }
            { const int r = lane & 31, xrow = 16 * ((r >> 2) & 1) + (r & 3) + 4 * (r >> 3); *(LAS bf16x8*)(XA + xrow * XA_STRIDE + 256 + 16 * (lane >> 5)) = aop; }
            LAS unsigned char* xw = XA + (16 * (lane >> 5)) * XA_STRIDE + 4 * (lane & 31);
#pragma unroll
            for (int i = 0; i < 16; ++i) {
#pragma unroll
                for (int sp = 0; sp < 2; ++sp) {
                    const float nxr = G.ar[sp] * xr[sp] - G.ai[sp] * xi[sp] + bu[sp][i];
                    const float nxi = G.ar[sp] * xi[sp] + G.ai[sp] * xr[sp] + bu[2 + sp][i];
                    xr[sp] = nxr; xi[sp] = nxi;
                    *(LAS unsigned*)(xw + i * XA_STRIDE + 128 * sp) = cvt_pk_bf16(nxr, nxi);
                }
            }
            asm volatile("s_waitcnt lgkmcnt(0)" ::: "memory");
#pragma unroll
            for (int rg = 0; rg < 2; ++rg) {
                f32x4 ay = {0.f, 0.f, 0.f, 0.f};
#pragma unroll
                for (int ks = 0; ks < 5; ++ks) {
                    const bf16x8 xf = *(const LAS bf16x8*)(XA + (16 * rg + (lane & 15)) * XA_STRIDE + 64 * ks + 16 * (lane >> 4));
                    ay = __builtin_amdgcn_mfma_f32_16x16x32_bf16(cf[ks], xf, ay, 0, 0, 0);
                }
                const int tok = c * 128 + 64 * rg + 16 * j + (lane & 15);
                u32x2 w; w.x = cvt_pk_bf16(gelu_tanh(ay[0]), gelu_tanh(ay[1])); w.y = cvt_pk_bf16(gelu_tanh(ay[2]), gelu_tanh(ay[3]));
                *(u32x2*)(P.ybuf() + (size_t)tok * 512 + 16 * g + 4 * (lane >> 4)) = w;
            }
            asm volatile("s_waitcnt lgkmcnt(0)" ::: "memory");
        }
    }
}


template <int W>
__device__ __forceinline__ void pool_channel(const Params& P, int c, int ch) {
    const int t0 = c * 128, pos0 = t0 & (SEQ - 1);
    const bf16_t* zc = P.z() + ch;
    float prev[16], cur[16];
#pragma unroll
    for (int i = 0; i < 16; ++i) prev[i] = (pos0 > 0) ? bf2f(zc[(size_t)(t0 - 16 + i) * DM]) : 0.f;
#pragma unroll 1
    for (int b = 0; b < 8; ++b) {
        const int tb = t0 + 16 * b, posb = pos0 + 16 * b;
#pragma unroll
        for (int i = 0; i < 16; ++i) cur[i] = bf2f(zc[(size_t)(tb + i) * DM]);
        VM_WAIT0();
#pragma unroll
        for (int i = 0; i < 16; ++i) {
            float a = 0.f;
#pragma unroll
            for (int j = 0; j < W; ++j) a += (i - j >= 0) ? cur[(i - j >= 0) ? i - j : 0] : prev[(i - j < 0) ? 16 + i - j : 0];
            const int pos = posb + i;
            const float inv = (pos + 1 < W) ? 1.0f / (float)(pos + 1) : (1.0f / (float)W);
            P.ycat()[(size_t)(tb + i) * DM + ch] = f2bf(a * inv - cur[i]);
        }
#pragma unroll
        for (int i = 0; i < 16; ++i) prev[i] = cur[i];
    }
}
__device__ __forceinline__ void phaseB_pool(const Params& P, int c, int tid) {
    const int gi = __builtin_amdgcn_readfirstlane(tid >> 7);
    if (gi == 0) pool_channel<2>(P, c, tid); else if (gi == 1) pool_channel<4>(P, c, tid); else if (gi == 2) pool_channel<8>(P, c, tid); else pool_channel<16>(P, c, tid);
}

__device__ __forceinline__ void phaseB_glu(const Params& P, LAS unsigned char* lds, int c, int tid) {
    const int wid = __builtin_amdgcn_readfirstlane(tid >> 6), lane = tid & 63, wr = wid >> 2, wc = wid & 3, fr = lane & 15, fq = lane >> 4;
#pragma unroll 1
    for (int nt_ = 0; nt_ < 2; ++nt_) {
        const int nt = (nt_ + c) & 1;
        StagePtrs sp; sp.a[2] = nullptr; sp.ksplit = 1 << 30; sp.bdelta = 0; sp.kt0 = (c >> 1) & 7; sp.nkt = 8;
#pragma unroll
        for (int j = 0; j < 2; ++j) { const int r = stage_row_a(wid, lane, j); sp.a[j] = (const char*)(P.ybuf() + (size_t)(c * 128 + r) * 512) + stage_chunk_off(r, lane); }
#pragma unroll
        for (int j = 0; j < 4; ++j) { const int r = stage_row_b(wid, lane, j); sp.b[j] = (const char*)(P.gluT() + (size_t)(nt * 256 + r) * 512) + stage_chunk_off(r, lane); }
        f32x4 acc[4][4]; acc_zero<4>(acc);
        f32x4 bb[4]; u32x2 ywa[4][4];
        const float* bres = P.glu_b + nt * 256 + wc * 64 + 4 * fq;
        const bf16_t* yres = P.ybuf() + ((size_t)c * 128 + wr * 64 + fr) * 512 + nt * 256 + wc * 64 + 4 * fq;
        auto pre = [&]() {
#pragma unroll
            for (int n = 0; n < 4; ++n) bb[n] = *(const f32x4*)(bres + n * 16);
#pragma unroll
            for (int m = 0; m < 4; ++m)
#pragma unroll
                for (int n = 0; n < 4; ++n) ywa[m][n] = *(const u32x2*)(yres + (size_t)m * 16 * 512 + n * 16);
            asm volatile("" ::: "memory");
        };
        gemm_core<4, 20>(lds, sp, 512 / 64, acc, wid, wr, wc, lane, nt_ == 0, pre);
        VM_WAIT0();
#pragma unroll
        for (int m = 0; m < 4; ++m) {
            const int row = c * 128 + wr * 64 + m * 16 + fr;
#pragma unroll
            for (int n = 0; n < 4; ++n) {
                const int col = nt * 256 + wc * 64 + n * 16 + 4 * fq;
                const u32x2 ywv = ywa[m][n];
                const float y0 = bflo(ywv.x), y1 = bfhi(ywv.x), y2 = bflo(ywv.y), y3 = bfhi(ywv.y);
                u32x2 w;
                w.x = cvt_pk_bf16(y0 / (1.0f + __expf(-(acc[m][n][0] + bb[n][0]))), y1 / (1.0f + __expf(-(acc[m][n][1] + bb[n][1]))));
                w.y = cvt_pk_bf16(y2 / (1.0f + __expf(-(acc[m][n][2] + bb[n][2]))), y3 / (1.0f + __expf(-(acc[m][n][3] + bb[n][3]))));
                *(u32x2*)(P.ycat() + (size_t)row * DM + 512 + col) = w;
            }
        }
    }
}

__device__ __forceinline__ void phaseB_wout(const Params& P, LAS unsigned char* lds, int c, int tid) {
    const int wid = __builtin_amdgcn_readfirstlane(tid >> 6), lane = tid & 63, wr = wid >> 2, wc = wid & 3, fr = lane & 15, fq = lane >> 4;
    LAS float* rowss = (LAS float*)(lds + MISC_OFF);
    LAS float* sspart = (LAS float*)(lds + MISC_OFF + 1024);
#pragma unroll 1
    for (int nt_ = 0; nt_ < 4; ++nt_) {
        const int nt = nt_;
        StagePtrs sp; sp.a[2] = nullptr; sp.ksplit = 1 << 30; sp.bdelta = 0; sp.kt0 = (c >> 2) & 15; sp.nkt = 16;
#pragma unroll
        for (int j = 0; j < 2; ++j) { const int r = stage_row_a(wid, lane, j); sp.a[j] = (const char*)(P.ycat() + (size_t)(c * 128 + r) * DM) + stage_chunk_off(r, lane); }
#pragma unroll
        for (int j = 0; j < 4; ++j) { const int r = stage_row_b(wid, lane, j); sp.b[j] = (const char*)(P.w_outT() + (size_t)(nt * 256 + r) * DM) + stage_chunk_off(r, lane); }
        f32x4 acc[4][4]; acc_zero<4>(acc);
        u32x2 xw[4][4];
        const bf16_t* xres = P.xb() + ((size_t)c * 128 + wr * 64 + fr) * DM + nt * 256 + wc * 64 + 4 * fq;
        auto pre = [&]() {
#pragma unroll
            for (int m = 0; m < 4; ++m)
#pragma unroll
                for (int n = 0; n < 4; ++n) xw[m][n] = *(const u32x2*)(xres + (size_t)m * 16 * DM + n * 16);
            asm volatile("" ::: "memory");
        };
        gemm_core<4, 16>(lds, sp, DM / 64, acc, wid, wr, wc, lane, nt_ == 0, pre);
        VM_WAIT0();
#pragma unroll
        for (int m = 0; m < 4; ++m) {
            const int lrow = wr * 64 + m * 16 + fr; const size_t row = (size_t)c * 128 + lrow;
            float ss = 0.f;
#pragma unroll
            for (int n = 0; n < 4; ++n) {
                const int col = nt * 256 + wc * 64 + n * 16 + 4 * fq;
                f32x4 v = acc[m][n]; v[0] += bflo(xw[m][n].x); v[1] += bfhi(xw[m][n].x); v[2] += bflo(xw[m][n].y); v[3] += bfhi(xw[m][n].y);
                u32x2 w; w.x = cvt_pk_bf16(v[0], v[1]); w.y = cvt_pk_bf16(v[2], v[3]);
                *(u32x2*)(P.x1b() + row * DM + col) = w;
                ss += v[0] * v[0] + v[1] * v[1] + v[2] * v[2] + v[3] * v[3];
            }
            ss += __shfl_xor(ss, 16); ss += __shfl_xor(ss, 32);
            if (fq == 0) sspart[lrow * 16 + nt * 4 + wc] = ss;
        }
    }
    VM_WAIT0();
    __syncthreads();
    if (tid < 128) { float t = 0.f;
#pragma unroll
        for (int q = 0; q < 16; ++q) t += sspart[tid * 16 + q];
        const float r = rsqrtf(t * (1.0f / DM) + EPSV); P.rstd2()[c * 128 + tid] = r; rowss[tid] = r; }
    __syncthreads();
}


#define LG_OFF (MISC_OFF + 1024)
#define CNT_OFF (MISC_OFF + 1024 + 10240)
__device__ __forceinline__ void phaseB_router(const Params& P, LAS unsigned char* lds, int c, int tid) {
    const int wid = tid >> 6, lane = tid & 63, l15 = lane & 15, fq = lane >> 4;
    LAS float* rowss = (LAS float*)(lds + MISC_OFF);
    LAS float* lg = (LAS float*)(lds + LG_OFF);
    LAS int* lcnt = (LAS int*)(lds + CNT_OFF);
    if (tid < 48) lcnt[tid] = 0;
    {
        f32x4 a0 = {0.f, 0.f, 0.f, 0.f}, a1 = {0.f, 0.f, 0.f, 0.f};
        const bf16_t* xr = P.x1b() + (size_t)(c * 128 + wid * 16 + l15) * DM + 8 * fq;
        const bf16_t* w0 = P.wrT() + (size_t)l15 * DM + 8 * fq;
        const bf16_t* w1 = P.wrT() + (size_t)(16 + l15) * DM + 8 * fq;
#pragma unroll 8
        for (int ks = 0; ks < 32; ++ks) {
            const bf16x8 xf = *(const bf16x8*)(xr + 32 * ks), f0 = *(const bf16x8*)(w0 + 32 * ks), f1 = *(const bf16x8*)(w1 + 32 * ks);
            a0 = __builtin_amdgcn_mfma_f32_16x16x32_bf16(f0, xf, a0, 0, 0, 0);
            a1 = __builtin_amdgcn_mfma_f32_16x16x32_bf16(f1, xf, a1, 0, 0, 0);
        }
        const int r = wid * 16 + l15;
#pragma unroll
        for (int q = 0; q < 4; ++q) lg[r * 20 + 4 * fq + q] = a0[q];
        if (fq == 0) {
#pragma unroll
            for (int q = 0; q < 4; ++q) lg[r * 20 + 16 + q] = a1[q];
        }
    }
    __syncthreads();
    int cls = 0, rank = 0; float wlo = 0.f, whi = 0.f;
    if (tid < 128) {
        const float rs = rowss[tid];
        float cl[4];
#pragma unroll
        for (int j = 0; j < 4; ++j) cl[j] = lg[tid * 20 + j] * rs + P.rc_b[j];
        int gi = 0; float mx = cl[0];
#pragma unroll
        for (int j = 1; j < 4; ++j) if (cl[j] > mx) { mx = cl[j]; gi = j; }
        float se = 0.f;
#pragma unroll
        for (int j = 0; j < 4; ++j) se += __expf(cl[j] - mx);
        const float pg = 1.0f / se;
        float f[4];
#pragma unroll
        for (int j = 0; j < 4; ++j) {
            float v = lg[tid * 20 + 4 + j] ;
            v = (gi == 1) ? lg[tid * 20 + 8 + j] : v; v = (gi == 2) ? lg[tid * 20 + 12 + j] : v; v = (gi == 3) ? lg[tid * 20 + 16 + j] : v;
            f[j] = v * rs + P.rf_b[gi * 4 + j];
        }
        int i0 = 0; float v0 = f[0];
#pragma unroll
        for (int j = 1; j < 4; ++j) if (f[j] > v0) { v0 = f[j]; i0 = j; }
        int i1 = -1; float v1 = 0.f;
#pragma unroll
        for (int j = 0; j < 4; ++j) if (j != i0 && (i1 < 0 || f[j] > v1)) { v1 = f[j]; i1 = j; }
        const float e1 = __expf(v1 - v0);
        const float wa = pg / (1.0f + e1), wb = pg * e1 / (1.0f + e1);
        const int lo = i0 < i1 ? i0 : i1, hi = i0 < i1 ? i1 : i0;
        wlo = (i0 < i1) ? wa : wb; whi = (i0 < i1) ? wb : wa;
        const int pidx = (lo == 0) ? (hi - 1) : ((lo == 1) ? (hi + 1) : 5);
        cls = gi * 6 + pidx;
        rank = __hip_atomic_fetch_add(&lcnt[cls], 1, __ATOMIC_RELAXED, __HIP_MEMORY_SCOPE_WORKGROUP);
    }
    __syncthreads();
    if (tid < 24) { const int n = lcnt[tid]; lcnt[24 + tid] = n ? (int)atomicAdd((unsigned*)P.ctl() + 64 + tid, (unsigned)n) : 0; }
    __syncthreads();
    if (tid < 128) {
        const int tok = c * 128 + tid;
        P.perm()[(size_t)cls * T_TOK + lcnt[24 + cls] + rank] = tok;
        P.tokw()[2 * tok] = wlo; P.tokw()[2 * tok + 1] = whi;
    }
}

#define C_ROWS 144
#define C_STAGE (C_ROWS * 128 + 32768)
#define C_MISC (3 * C_STAGE)
#define C_TOK_OFF (C_MISC)
#define C_RS_OFF (C_MISC + 576)
#define C_WL_OFF (C_MISC + 1152)
#define C_WH_OFF (C_MISC + 1728)
#define C_SS_OFF (C_MISC + 2304)
__device__ __forceinline__ void phaseC(const Params& P, LAS unsigned char* lds, int bid, int nblk, int tid_) {
    int tid = tid_;
    const int wid = __builtin_amdgcn_readfirstlane(tid >> 6), wr = wid >> 2, wc = wid & 3;
    const int rowbase = wr ? 80 : 0;
    LAS int* rowtok = (LAS int*)(lds + C_TOK_OFF);
    LAS float* rsv = (LAS float*)(lds + C_RS_OFF);
    LAS float* wlv = (LAS float*)(lds + C_WL_OFF);
    LAS float* whv = (LAS float*)(lds + C_WH_OFF);
    LAS float* sspart = (LAS float*)(lds + C_SS_OFF);
    const unsigned* gcnt = P.ctl() + 64;
    int total = 0;
    for (int k = 0; k < 24; ++k) total += ((int)gcnt[k] + C_ROWS - 1) / C_ROWS;
    for (int u = bid; u < total; u += nblk) {
        int cls = 0, j = u, cnt = 0;
        for (int k = 0; k < 24; ++k) { const int n = (int)gcnt[k], t = (n + C_ROWS - 1) / C_ROWS; if (j < t) { cls = k; cnt = n; break; } j -= t; }
        const int ntile = (cnt + C_ROWS - 1) / C_ROWS, rbeg = (int)(((long)cnt * j) / ntile), rend = (int)(((long)cnt * (j + 1)) / ntile), nvalid = rend - rbeg;
        __syncthreads();
        if (tid < C_ROWS) {
            const int r = tid < nvalid ? tid : nvalid - 1;
            const int tok = P.perm()[(size_t)cls * T_TOK + rbeg + r];
            rowtok[tid] = tok; rsv[tid] = P.rstd2()[tok]; wlv[tid] = P.tokw()[2 * tok]; whv[tid] = P.tokw()[2 * tok + 1];
        }
        __syncthreads();
        const int gi = cls / 6, pidx = cls - gi * 6;
        const int lo = pidx < 3 ? 0 : (pidx < 5 ? 1 : 2), hi = pidx < 3 ? pidx + 1 : (pidx < 5 ? pidx - 1 : 3);
        const int e_lo = gi * 4 + lo, e_hi = gi * 4 + hi;
        bf16_t* hid = P.hid() + (size_t)u * C_ROWS * 512;
        bf16_t* x2s = P.z() + (size_t)u * C_ROWS * DM;
        { asm volatile("" : "+v"(tid)); const int lane = tid & 63, fr = lane & 15, fq = lane >> 4;
#pragma unroll 1
        for (int s = 0; s < 2; ++s) {
            const int e = s ? e_hi : e_lo;
#pragma unroll 1
            for (int ch = 0; ch < 2; ++ch) {
                StagePtrs sp; sp.ksplit = 1 << 30; sp.bdelta = 0; sp.kt0 = 0; sp.nkt = 1 << 30;
#pragma unroll
                for (int q = 0; q < 3; ++q) { const int r = stage_row_a(wid, lane, q) < C_ROWS ? stage_row_a(wid, lane, q) : 0; sp.a[q] = (const char*)(P.x1b() + (size_t)rowtok[r] * DM) + stage_chunk_off(r, lane); }
#pragma unroll
                for (int q = 0; q < 4; ++q) { const int r = stage_row_b(wid, lane, q); sp.b[q] = (const char*)(P.wguT() + ((size_t)(e * 2 + ch) * 256 + r) * DM) + stage_chunk_off(r, lane); }
                f32x4 acc[5][4]; acc_zero<5>(acc);
                gemm_core<5>(lds, sp, DM / 64, acc, wid, wr, wc, lane, s == 0 && ch == 0);
#pragma unroll
                for (int m = 0; m < 5; ++m) if (m < 4 || wr == 0) {
                    const int r = rowbase + m * 16 + fr; const float rs = rsv[r], wsel = s ? whv[r] : wlv[r];
#pragma unroll
                    for (int n = 0; n < 2; ++n) {
                        float h[4];
#pragma unroll
                        for (int q = 0; q < 4; ++q) { const float g = acc[m][n][q] * rs, uu = acc[m][n + 2][q] * rs; h[q] = g / (1.0f + __expf(-g)) * uu * wsel; }
                        u32x2 w; w.x = cvt_pk_bf16(h[0], h[1]); w.y = cvt_pk_bf16(h[2], h[3]);
                        *(u32x2*)(hid + (size_t)r * 512 + 256 * s + 128 * ch + 32 * wc + 16 * n + 4 * fq) = w;
                    }
                    asm volatile("" ::: "memory");
                }
            }
        }
        }
        { asm volatile("" : "+v"(tid)); const int lane = tid & 63, fr = lane & 15, fq = lane >> 4;
        float ssr[5] = {0.f, 0.f, 0.f, 0.f, 0.f};
#pragma unroll 1
        for (int nt = 0; nt < 4; ++nt) {
            StagePtrs sp; sp.ksplit = 4; sp.bdelta = (long)(e_hi - e_lo) * DM * 256 * 2; sp.kt0 = 0; sp.nkt = 1 << 30;
#pragma unroll
            for (int q = 0; q < 3; ++q) { const int r = stage_row_a(wid, lane, q) < C_ROWS ? stage_row_a(wid, lane, q) : 0; sp.a[q] = (const char*)(hid + (size_t)r * 512) + stage_chunk_off(r, lane); }
#pragma unroll
            for (int q = 0; q < 4; ++q) { const int r = stage_row_b(wid, lane, q); sp.b[q] = (const char*)(P.wdT() + ((size_t)e_lo * DM + nt * 256 + r) * 256) + stage_chunk_off(r, lane); }
            f32x4 acc[5][4]; acc_zero<5>(acc);
            gemm_core<5>(lds, sp, 8, acc, wid, wr, wc, lane, nt == 0);
#pragma unroll
            for (int m = 0; m < 5; ++m) if (m < 4 || wr == 0) {
                const int r = rowbase + m * 16 + fr;
                if (r < nvalid) {
                    const bf16_t* xrow = P.x1b() + (size_t)rowtok[r] * DM + nt * 256 + wc * 64 + 4 * fq; bf16_t* srow = x2s + (size_t)r * DM + nt * 256 + wc * 64 + 4 * fq; float ss = 0.f;
                    u32x2 xwv[4];
#pragma unroll
                    for (int n = 0; n < 4; ++n) xwv[n] = *(const u32x2*)(xrow + n * 16);
                    VM_WAIT0();
#pragma unroll
                    for (int n = 0; n < 4; ++n) { const u32x2 xw = xwv[n]; f32x4 v = acc[m][n]; v[0] += bflo(xw.x); v[1] += bfhi(xw.x); v[2] += bflo(xw.y); v[3] += bfhi(xw.y);
                        u32x2 w; w.x = cvt_pk_bf16(v[0], v[1]); w.y = cvt_pk_bf16(v[2], v[3]); *(u32x2*)(srow + n * 16) = w; ss += v[0] * v[0] + v[1] * v[1] + v[2] * v[2] + v[3] * v[3]; }
                    ssr[m] += ss;
                }
                asm volatile("" ::: "memory");
            }
        }
#pragma unroll
        for (int m = 0; m < 5; ++m) if (m < 4 || wr == 0) {
            float ss = ssr[m]; ss += __shfl_xor(ss, 16); ss += __shfl_xor(ss, 32);
            if (fq == 0) sspart[(rowbase + m * 16 + fr) * 4 + wc] = ss;
        }
        }
        __syncthreads();
        { asm volatile("" : "+v"(tid)); const int lane = tid & 63, fr = lane & 15, fq = lane >> 4;
        float rs3[5];
#pragma unroll
        for (int m = 0; m < 5; ++m) { const int r = rowbase + m * 16 + fr; const int rr = (m < 4 || wr == 0) ? r : 0;
            const float tsum = (sspart[rr * 4] + sspart[rr * 4 + 1]) + (sspart[rr * 4 + 2] + sspart[rr * 4 + 3]); rs3[m] = rsqrtf(tsum * (1.0f / DM) + EPSV); }
        f32x4 gv[2][4]; u32x2 xwv[2][5][4];
#define C3_LOAD(buf, nt) do { \
            _Pragma("unroll") for (int n = 0; n < 4; ++n) gv[buf][n] = *(const f32x4*)(P.norm_final + (nt) * 256 + wc * 64 + 4 * fq + n * 16); \
            _Pragma("unroll") for (int m = 0; m < 5; ++m) if (m < 4 || wr == 0) { const int r = rowbase + m * 16 + fr; const bf16_t* srow = x2s + (size_t)(r < nvalid ? r : 0) * DM + (nt) * 256 + wc * 64 + 4 * fq; \
                _Pragma("unroll") for (int n = 0; n < 4; ++n) xwv[buf][m][n] = *(const u32x2*)(srow + n * 16); } } while (0)
        C3_LOAD(0, 0);
#pragma unroll
        for (int nt = 0; nt < 4; ++nt) {
            VM_WAIT0();
            if (nt + 1 < 4) C3_LOAD((nt + 1) & 1, nt + 1);
            asm volatile("" ::: "memory");
#pragma unroll
            for (int m = 0; m < 5; ++m) if (m < 4 || wr == 0) {
                const int r = rowbase + m * 16 + fr;
                if (r < nvalid) {
                    float* orow = P.out + (size_t)rowtok[r] * DM + nt * 256 + wc * 64 + 4 * fq;
#pragma unroll
                    for (int n = 0; n < 4; ++n) { const f32x4 g = gv[nt & 1][n]; const u32x2 xw = xwv[nt & 1][m][n]; const float rs = rs3[m];
                        f32x4 v; v[0] = bflo(xw.x) * rs * g[0]; v[1] = bfhi(xw.x) * rs * g[1]; v[2] = bflo(xw.y) * rs * g[2]; v[3] = bfhi(xw.y) * rs * g[3]; __builtin_nontemporal_store(v, (f32x4*)(orow + n * 16)); }
                }
            }
            asm volatile("" ::: "memory");
        }
#undef C3_LOAD
        }
    }
}


static void fill_params(Params& P, void* const* d_in, void* d_out, void* d_ws) {
    memset(&P, 0, sizeof(P));
    P.x = (const float*)d_in[0]; P.norm_mix = (const float*)d_in[1]; P.w_in = (const float*)d_in[2]; P.pool_w = (const float*)d_in[3]; P.pool_scale = (const float*)d_in[4];
    P.a_re = (const float*)d_in[5]; P.a_im = (const float*)d_in[6]; P.log_step = (const float*)d_in[7]; P.b_re = (const float*)d_in[8]; P.b_im = (const float*)d_in[9];
    P.c_re = (const float*)d_in[10]; P.c_im = (const float*)d_in[11]; P.ssm_d = (const float*)d_in[12]; P.glu_w = (const float*)d_in[13]; P.glu_b = (const float*)d_in[14];
    P.w_out = (const float*)d_in[15]; P.norm_ffn = (const float*)d_in[16]; P.rc_w = (const float*)d_in[17]; P.rc_b = (const float*)d_in[18]; P.rf_w = (const float*)d_in[19]; P.rf_b = (const float*)d_in[20];
    P.wg = (const float*)d_in[21]; P.wu = (const float*)d_in[22]; P.wd = (const float*)d_in[23]; P.norm_final = (const float*)d_in[24];
    P.out = (float*)d_out;
    P.ws = (char*)d_ws;
}
#define CTL_BYTES 65536

__global__ void __launch_bounds__(NTHR) mk_forward(Params P) {
    extern __shared__ __attribute__((aligned(16))) unsigned char lds_raw[];
    LAS unsigned char* lds = (LAS unsigned char*)lds_raw;
    const int bid = blockIdx.x, nblk = gridDim.x; int tid = threadIdx.x;
#define OPAQUE_TID() asm volatile("" : "+v"(tid))
    volatile LAS unsigned* xb_st = (volatile LAS unsigned*)(lds + LDS_BYTES - 16);
    if (tid < 4) xb_st[tid] = 0u;
    __syncthreads();
    const XcdBarrier xb = xcd_barrier_post(P.ctl(), xb_st);
    OPAQUE_TID();
    phase0_x(P, bid, nblk, tid);
    phase0_ssm(P, bid, nblk, tid);
    phase0_weights(P, bid, nblk, tid, (LAS float*)lds);
    xcd_barrier(xb);
    for (int mt = bid; mt < T_TOK / 128; mt += nblk) {
        OPAQUE_TID();
        phaseA_tile(P, lds, mt, mt >> 3, tid);
        VM_WAIT0();
        __syncthreads();
        OPAQUE_TID();
        phaseA2_chunk(P, mt, tid);
    }
    xcd_barrier(xb);
    for (int c = bid; c < T_TOK / 128; c += nblk) {
        __syncthreads();
        OPAQUE_TID();
        phaseB_ssm(P, lds, c, tid);
        __syncthreads();
        OPAQUE_TID();
        phaseB_pool(P, c, tid);
        OPAQUE_TID();
        phaseB_glu(P, lds, c, tid);
        OPAQUE_TID();
        phaseB_wout(P, lds, c, tid);
        OPAQUE_TID();
        phaseB_router(P, lds, c, tid);
    }
    xcd_barrier(xb);
    OPAQUE_TID();
    phaseC(P, lds, bid, nblk, tid);
}

extern "C" void kernel_launch(void* const* d_in, const int* in_sizes, int n_in, void* d_out, int out_size, void* d_ws, size_t ws_size, hipStream_t stream) {
    static int grid_blocks = 0;
    if (!grid_blocks) {
        int dev = 0, cus = 0, per_cu = 0;
        (void)hipGetDevice(&dev);
        (void)hipDeviceGetAttribute(&cus, hipDeviceAttributeMultiprocessorCount, dev);
        (void)hipFuncSetAttribute((const void*)mk_forward, hipFuncAttributeMaxDynamicSharedMemorySize, LDS_BYTES);
        (void)hipOccupancyMaxActiveBlocksPerMultiprocessor(&per_cu, (const void*)mk_forward, NTHR, LDS_BYTES);
        if (per_cu < 1) per_cu = 1;
        grid_blocks = cus * per_cu; if (grid_blocks > 256) grid_blocks = 256;
    }
    Params P; fill_params(P, d_in, d_out, d_ws);
    (void)hipMemsetAsync(d_ws, 0, CTL_BYTES, stream);
    void* args[] = {&P};
    hipError_t e = hipLaunchCooperativeKernel((const void*)mk_forward, dim3(grid_blocks), dim3(NTHR), args, LDS_BYTES, stream);
    if (e != hipSuccess) fprintf(stderr, "cooperative launch failed: %s (grid %d)\n", hipGetErrorString(e), grid_blocks);
}
```
